# Optimizing an MI355X kernel written in HIP

```python
import math
import jax, jax.numpy as jnp
from jax import lax
import numpy as np

D_MODEL = 1024
BATCH = 4
SEQ = 4096
DEPTH = 4

N_MIXERS = 3
D_FF = 2816
LN_EPS = 1e-5
DEEPNORM_ALPHA = (2 * DEPTH) ** 0.25
DEEPNORM_BETA = (8 * DEPTH) ** -0.25
A_HEADS = 8
A_HEAD_DIM = D_MODEL // A_HEADS
MOBA_BLOCK = 256
MOBA_TOPK = 3
MOBA_Q_CHUNK = 32
REL_BUCKETS = 32
REL_MAX_EXACT = REL_BUCKETS // 2
REL_MAX_DIST = 128
POOL_WINDOWS = (2, 4, 8, 16)
POOL_GROUP = D_MODEL // len(POOL_WINDOWS)
C_HEADS = 4
C_HEAD_DIM = D_MODEL // C_HEADS
C_CONV = 4
C_CHUNK = 64
N_A = len(range(0, DEPTH, N_MIXERS))
N_B = len(range(1, DEPTH, N_MIXERS))
N_C = len(range(2, DEPTH, N_MIXERS))

kernel_name = "hybrid_moba_pool_mlstm_macaron_deepnorm"


def layer_norm(x, g, b):
    xf = x.astype(jnp.float32)
    mu = jnp.mean(xf, axis=-1, keepdims=True)
    var = jnp.mean(jnp.square(xf - mu), axis=-1, keepdims=True)
    y = (xf - mu) * lax.rsqrt(var + LN_EPS)
    return (y * g.astype(jnp.float32) + b.astype(jnp.float32)).astype(x.dtype)


def swiglu(x, w_gu, w_down):
    g, u = jnp.split(x @ w_gu, 2, axis=-1)
    return (jax.nn.silu(g) * u) @ w_down


def t5_bucket(dist):
    n = jnp.maximum(dist, 0)
    is_small = n < REL_MAX_EXACT
    nf = jnp.maximum(n, 1).astype(jnp.float32)
    large = REL_MAX_EXACT + (jnp.log(nf / REL_MAX_EXACT) / math.log(REL_MAX_DIST / REL_MAX_EXACT)
                             * (REL_BUCKETS - REL_MAX_EXACT)).astype(jnp.int32)
    large = jnp.minimum(large, REL_BUCKETS - 1)
    return jnp.where(is_small, n, large)


def moba_attention(h, w_in, w_out, rel_bias):
    B, S, _ = h.shape
    H, dh, blk, qcs = A_HEADS, A_HEAD_DIM, MOBA_BLOCK, MOBA_Q_CHUNK
    qkv = (h @ w_in).reshape(B, S, 3, H, dh)
    q, k, v = [jnp.transpose(qkv[:, :, j], (0, 2, 1, 3)) for j in range(3)]
    nb = -(-S // blk)
    pad = nb * blk - S
    kb = jnp.pad(k, ((0, 0), (0, 0), (0, pad), (0, 0))).reshape(B, H, nb, blk, dh)
    vb = jnp.pad(v, ((0, 0), (0, 0), (0, pad), (0, 0))).reshape(B, H, nb, blk, dh)
    q_block = jnp.arange(S) // blk
    n_sel = min(MOBA_TOPK, nb - 1)
    scale = dh ** -0.5
    rel_t = rel_bias.T
    bi = jnp.arange(B)[:, None, None, None]
    hi = jnp.arange(H)[None, :, None, None]
    if n_sel > 0:
        k_mean = jnp.mean(kb.astype(jnp.float32), axis=3)
        gate = jnp.einsum('bhsd,bhnd->bhsn', q.astype(jnp.float32), k_mean)
        past = jnp.arange(nb)[None, :] < q_block[:, None]
        gate = jnp.where(past, gate, -jnp.inf)
        _, top_idx = lax.top_k(gate, n_sel)
        top_valid = top_idx < q_block[:, None]

    def chunk_attend(c):
        start = c * qcs
        qc = lax.dynamic_slice_in_dim(q, start, qcs, axis=2)
        qpos = start + jnp.arange(qcs)
        j = start // blk
        ko = lax.dynamic_index_in_dim(kb, j, axis=2, keepdims=False)
        vo = lax.dynamic_index_in_dim(vb, j, axis=2, keepdims=False)
        kpos = j * blk + jnp.arange(blk)
        dist = qpos[:, None] - kpos[None, :]
        bias_own = jnp.transpose(rel_bias[t5_bucket(dist)], (2, 0, 1))
        s_own = jnp.einsum('bhqd,bhkd->bhqk', qc, ko) * scale + bias_own
        s_own = jnp.where(dist >= 0, s_own, -jnp.inf).astype(jnp.float32)
        if n_sel > 0:
            idx = lax.dynamic_slice_in_dim(top_idx, start, qcs, axis=2)
            valid = lax.dynamic_slice_in_dim(top_valid, start, qcs, axis=2)
            kg = kb[bi, hi, idx]
            vg = vb[bi, hi, idx]
            kpos_sel = idx[..., None] * blk + jnp.arange(blk)
            bucket = t5_bucket(qpos[:, None, None] - kpos_sel)
            s_sel = jnp.einsum('bhqd,bhqnkd->bhqnk', qc, kg) * scale + rel_t[hi[..., None], bucket]
            s_sel = jnp.where(valid[..., None], s_sel, -jnp.inf).astype(jnp.float32)
            logits = jnp.concatenate([s_own, s_sel.reshape(B, H, qcs, n_sel * blk)], axis=-1)
            p = jax.nn.softmax(logits, axis=-1).astype(v.dtype)
            out = (jnp.einsum('bhqk,bhkd->bhqd', p[..., :blk], vo)
                   + jnp.einsum('bhqnk,bhqnkd->bhqd', p[..., blk:].reshape(B, H, qcs, n_sel, blk), vg))
        else:
            p = jax.nn.softmax(s_own, axis=-1).astype(v.dtype)
            out = jnp.einsum('bhqk,bhkd->bhqd', p, vo)
        return out

    outs = lax.map(chunk_attend, jnp.arange(S // qcs))
    o = jnp.transpose(outs, (1, 0, 3, 2, 4)).reshape(B, S, H * dh)
    return o @ w_out


def pool_mixer(h, w_in, w_group, scale, w_out):
    B, S, _ = h.shape
    u = h @ w_in
    counts = jnp.arange(1, S + 1, dtype=jnp.float32)
    pooled = []
    for g, w in enumerate(POOL_WINDOWS):
        ug = u[..., g * POOL_GROUP:(g + 1) * POOL_GROUP].astype(jnp.float32)
        cs = jnp.cumsum(ug, axis=1)
        cs_lag = jnp.pad(cs, ((0, 0), (w, 0), (0, 0)))[:, :S]
        mean = (cs - cs_lag) / jnp.minimum(counts, float(w))[:, None]
        pooled.append(mean - ug)
    p = jnp.stack(pooled, axis=2).astype(h.dtype)
    y = jnp.einsum('bsgc,gcd->bsgd', p, w_group).reshape(B, S, D_MODEL) * scale
    return y @ w_out


def causal_conv(x, w):
    S = x.shape[1]
    xp = jnp.pad(x, ((0, 0), (C_CONV - 1, 0), (0, 0)))
    y = w[0] * xp[:, 0:S]
    for j in range(1, C_CONV):
        y = y + w[j] * xp[:, j:j + S]
    return y


def mlstm_chunkwise(q, k, v, i_pre, log_f):
    B, H, S, dh = q.shape
    L = C_CHUNK
    nc = S // L

    def to_chunks(t):
        return jnp.moveaxis(t.reshape((B, H, nc, L) + t.shape[3:]), 2, 0)

    qc, kc, vc, ic = to_chunks(q), to_chunks(k), to_chunks(v), to_chunks(i_pre)
    bc = jnp.cumsum(to_chunks(log_f), axis=-1)
    causal = jnp.tril(jnp.ones((L, L), dtype=bool))

    def step(carry, xs):
        C, n, m = carry
        qx, kx, vx, ix, bx = xs
        d_intra = jnp.where(causal, bx[..., :, None] - bx[..., None, :] + ix[..., None, :], -jnp.inf)
        m_inter = bx + m[..., None]
        m_t = jnp.maximum(m_inter, jnp.max(d_intra, axis=-1))
        w = jnp.exp(d_intra - m_t[..., None]) * jnp.einsum('bhtd,bhsd->bhts', qx, kx)
        s_inter = jnp.exp(m_inter - m_t)
        num = s_inter[..., None] * jnp.einsum('bhtk,bhkv->bhtv', qx, C) + jnp.einsum('bhts,bhsv->bhtv', w, vx)
        den = s_inter * jnp.einsum('bhtk,bhk->bht', qx, n) + jnp.sum(w, axis=-1)
        h = num / jnp.maximum(jnp.abs(den), jnp.exp(-m_t))[..., None]
        b_last = bx[..., -1]
        g = b_last[..., None] - bx + ix
        m_new = jnp.maximum(b_last + m, jnp.max(g, axis=-1))
        decay = jnp.exp(b_last + m - m_new)
        wk = jnp.exp(g - m_new[..., None])
        C = decay[..., None, None] * C + jnp.einsum('bhsk,bhsv->bhkv', kx * wk[..., None], vx)
        n = decay[..., None] * n + jnp.einsum('bhs,bhsk->bhk', wk, kx)
        return (C, n, m_new), h

    init = (jnp.zeros((B, H, dh, dh), jnp.float32), jnp.zeros((B, H, dh), jnp.float32),
            jnp.zeros((B, H), jnp.float32))
    _, hs = lax.scan(step, init, (qc, kc, vc, ic, bc))
    return jnp.moveaxis(hs, 0, 2).reshape(B, H, S, dh)


def mlstm_mixer(h, w_in, b_gates, conv_w, norm_g, w_out):
    B, S, _ = h.shape
    H, dh, D = C_HEADS, C_HEAD_DIM, D_MODEL
    proj = h @ w_in
    qk = jax.nn.silu(causal_conv(proj[..., :2 * D], conv_w))
    v = proj[..., 2 * D:3 * D]
    o_pre = proj[..., 3 * D:4 * D]
    gates = (proj[..., 4 * D:] + b_gates).astype(jnp.float32)

    def heads(t):
        return jnp.transpose(t.reshape(B, S, H, dh).astype(jnp.float32), (0, 2, 1, 3))

    i_pre = jnp.transpose(gates[..., :H], (0, 2, 1))
    log_f = jnp.transpose(jax.nn.log_sigmoid(gates[..., H:]), (0, 2, 1))
    ht = mlstm_chunkwise(heads(qk[..., :D]), heads(qk[..., D:]) * dh ** -0.5, heads(v), i_pre, log_f)
    ht = jnp.transpose(ht, (0, 2, 1, 3))
    hc = jax.nn.sigmoid(o_pre.astype(jnp.float32)).reshape(B, S, H, dh) * ht
    mu = jnp.mean(hc, axis=-1, keepdims=True)
    var = jnp.mean(jnp.square(hc - mu), axis=-1, keepdims=True)
    hn = ((hc - mu) * lax.rsqrt(var + LN_EPS)).reshape(B, S, D) * norm_g.astype(jnp.float32)
    return hn.astype(h.dtype) @ w_out


def setup_inputs(seed: int = 0) -> dict:
    key = jax.random.key(seed)
    ks = jax.random.split(key, 18)
    D, H, GC = D_MODEL, C_HEADS, POOL_GROUP

    def nrm(k, shape, std):
        return jax.random.normal(k, shape, jnp.float32) * std

    x = nrm(ks[0], (BATCH, SEQ, D), 1.0)
    rel_bias = nrm(ks[1], (REL_BUCKETS, A_HEADS), 0.2)
    ln_g = 1.0 + nrm(ks[2], (DEPTH, 3, D), 0.02)
    ln_b = nrm(ks[3], (DEPTH, 3, D), 0.02)
    ffn_w_gu = nrm(ks[4], (DEPTH, 2, D, 2 * D_FF), D ** -0.5)
    ffn_w_down = nrm(ks[5], (DEPTH, 2, D_FF, D), D_FF ** -0.5 * DEEPNORM_BETA)
    a_w_in = nrm(ks[6], (N_A, D, 3 * D), D ** -0.5)
    a_w_out = nrm(ks[7], (N_A, D, D), D ** -0.5 * DEEPNORM_BETA)
    b_w_in = nrm(ks[8], (N_B, D, D), D ** -0.5)
    b_w_group = nrm(ks[9], (N_B, len(POOL_WINDOWS), GC, GC), GC ** -0.5)
    b_scale = 1.0 + nrm(ks[10], (N_B, D), 0.1)
    b_w_out = nrm(ks[11], (N_B, D, D), D ** -0.5 * DEEPNORM_BETA)
    c_w_in = nrm(ks[12], (N_C, D, 4 * D + 2 * H), D ** -0.5)
    c_b_gates = jnp.concatenate([nrm(ks[13], (N_C, H), 0.1),
                                 jnp.linspace(3.0, 6.0, H, dtype=jnp.float32)[None, :] + nrm(ks[14], (N_C, H), 0.1)],
                                axis=-1)
    c_conv_w = nrm(ks[15], (N_C, C_CONV, 2 * D), C_CONV ** -0.5)
    c_norm_g = 1.0 + nrm(ks[16], (N_C, D), 0.02)
    c_w_out = nrm(ks[17], (N_C, D, D), D ** -0.5 * DEEPNORM_BETA)
    return {"x": x, "rel_bias": rel_bias, "ln_g": ln_g, "ln_b": ln_b,
            "ffn_w_gu": ffn_w_gu, "ffn_w_down": ffn_w_down,
            "a_w_in": a_w_in, "a_w_out": a_w_out,
            "b_w_in": b_w_in, "b_w_group": b_w_group, "b_scale": b_scale, "b_w_out": b_w_out,
            "c_w_in": c_w_in, "c_b_gates": c_b_gates, "c_conv_w": c_conv_w, "c_norm_g": c_norm_g,
            "c_w_out": c_w_out}


def reference(x, rel_bias, ln_g, ln_b, ffn_w_gu, ffn_w_down, a_w_in, a_w_out,
              b_w_in, b_w_group, b_scale, b_w_out,
              c_w_in, c_b_gates, c_conv_w, c_norm_g, c_w_out):
    for i in range(DEPTH):
        x = layer_norm(DEEPNORM_ALPHA * x + 0.5 * swiglu(x, ffn_w_gu[i, 0], ffn_w_down[i, 0]),
                       ln_g[i, 0], ln_b[i, 0])
        kind, j = i % N_MIXERS, i // N_MIXERS
        if kind == 0:
            y = moba_attention(x, a_w_in[j], a_w_out[j], rel_bias)
        elif kind == 1:
            y = pool_mixer(x, b_w_in[j], b_w_group[j], b_scale[j], b_w_out[j])
        else:
            y = mlstm_mixer(x, c_w_in[j], c_b_gates[j], c_conv_w[j], c_norm_g[j], c_w_out[j])
        x = layer_norm(DEEPNORM_ALPHA * x + y, ln_g[i, 1], ln_b[i, 1])
        x = layer_norm(DEEPNORM_ALPHA * x + 0.5 * swiglu(x, ffn_w_gu[i, 1], ffn_w_down[i, 1]),
                       ln_g[i, 2], ln_b[i, 2])
    return x
```

```cpp
#include <hip/hip_runtime.h>
#include <hip/hip_cooperative_groups.h>
#include <cstdio>
#include <cstdint>
namespace cg = cooperative_groups;
namespace pg8 {
#define PG8_LAS __attribute__((address_space(3)))
typedef unsigned short bf16_t;
typedef short bf16x8 __attribute__((ext_vector_type(8)));
typedef float f32x4 __attribute__((ext_vector_type(4)));
typedef unsigned u32x4 __attribute__((ext_vector_type(4)));
constexpr int BM = 256, BK = 64, HALF = 128, HTB = HALF * BK * 2  , STAGE_BYTES = 8 * HTB, NXCD = 8, WGM = 8;

__host__ __device__ __forceinline__ int lds_byte(int r, int c) { const int st = (r >> 4) * 2 + (c >> 5), rr = r & 15, cc = c & 31, ob = rr * 64 + cc * 2; return st * 1024 + (ob ^ (((ob >> 9) & 1) << 5)); }
__host__ __device__ __forceinline__ void stage_rc(int b, int& R, int& C) { const int st = b / 1024, sb = b % 1024, swz = sb ^ (((sb >> 9) & 1) << 5); R = (st >> 1) * 16 + swz / 64; C = (st & 1) * 32 + (swz % 64) / 2; }
__host__ __device__ __forceinline__ int perm32(int rho) { const int n = rho >> 4, i = rho & 15; return 8 * (i >> 2) + 4 * n + (i & 3); }

struct Unit { int pm, pn; };
struct Gemm { const bf16_t* A; const bf16_t* Bt; int M, N, K; };

struct StaticOrder {
    int nM, nN, nwg, G, c;
    __host__ __device__ void init(int M, int N, int G_, int c_) { nM = M / BM; nN = N / BM; nwg = nM * nN; G = G_; c = c_; }
    __host__ __device__ bool next(int i, Unit& u) const {
        const long L = (long)i * G + c; if (L >= nwg) return false;
        int wgid = (int)L; { const int q = nwg / NXCD, r = nwg % NXCD, xcd = wgid % NXCD, off = wgid / NXCD; wgid = (xcd < r ? xcd * (q + 1) : r * (q + 1) + (xcd - r) * q) + off; }
        const int nig = WGM * nN, gid = wgid / nig, fm = gid * WGM, gsz = (nM - fm) < WGM ? (nM - fm) : WGM;
        u.pm = fm + ((wgid % nig) % gsz); u.pn = (wgid % nig) / gsz; return true;
    }
    __device__ __forceinline__ void a_ready(const Unit&) const {}
    __device__ __forceinline__ void done(const Unit&) const {}
};

__device__ __forceinline__ unsigned cvt_pk_bf16(float lo, float hi) { unsigned r; asm volatile("v_cvt_pk_bf16_f32 %0, %1, %2" : "=v"(r) : "v"(lo), "v"(hi)); return r; }
struct EpiBf16 {
    static constexpr bool PERM = true, AFTER_DRAIN = false;
    bf16_t* O; int ldc;
    __device__ __forceinline__ void operator()(const f32x4 (&acc)[2][2][4][2], const Unit& u, int wr, int wc, int fr, int fq) const {
        const int row0 = u.pm * BM + wr * 64 + fr; const int col0 = u.pn * BM + wc * 32 + 8 * fq;
#pragma unroll
        for (int ai = 0; ai < 2; ++ai)
#pragma unroll
            for (int m = 0; m < 4; ++m) { bf16_t* rowp = O + (size_t)(row0 + ai * HALF + m * 16) * ldc + col0;
#pragma unroll
                for (int bj = 0; bj < 2; ++bj) { const f32x4 v0 = acc[ai][bj][m][0], v1 = acc[ai][bj][m][1];
                    u32x4 w; w.x = cvt_pk_bf16(v0[0], v0[1]); w.y = cvt_pk_bf16(v0[2], v0[3]); w.z = cvt_pk_bf16(v1[0], v1[1]); w.w = cvt_pk_bf16(v1[2], v1[3]);
                    *(u32x4*)(rowp + bj * HALF) = w; } }
    }
};
__device__ __forceinline__ float silu_f(float g) { return g * __builtin_amdgcn_rcpf(1.0f + __builtin_amdgcn_exp2f(-1.44269504089f * g)); }
struct EpiSwiglu {
    static constexpr bool PERM = true, AFTER_DRAIN = false;
    bf16_t* O; int ldc;
    __device__ __forceinline__ void operator()(const f32x4 (&acc)[2][2][4][2], const Unit& u, int wr, int wc, int fr, int fq) const {
        const int row0 = u.pm * BM + wr * 64 + fr; const int col0 = u.pn * HALF + wc * 32 + 8 * fq;
#pragma unroll
        for (int ai = 0; ai < 2; ++ai)
#pragma unroll
            for (int m = 0; m < 4; ++m) { bf16_t* rowp = O + (size_t)(row0 + ai * HALF + m * 16) * ldc + col0;
                const f32x4 g0 = acc[ai][0][m][0], g1 = acc[ai][0][m][1], u0 = acc[ai][1][m][0], u1 = acc[ai][1][m][1];
                u32x4 w;
                w.x = cvt_pk_bf16(silu_f(g0[0]) * u0[0], silu_f(g0[1]) * u0[1]); w.y = cvt_pk_bf16(silu_f(g0[2]) * u0[2], silu_f(g0[3]) * u0[3]);
                w.z = cvt_pk_bf16(silu_f(g1[0]) * u1[0], silu_f(g1[1]) * u1[1]); w.w = cvt_pk_bf16(silu_f(g1[2]) * u1[2], silu_f(g1[3]) * u1[3]);
                *(u32x4*)rowp = w; }
    }
};
struct EpiPreLN {
    static constexpr bool PERM = false, AFTER_DRAIN = false;
    const float* X; float* Y; float alpha, c;
    __device__ __forceinline__ void operator()(const f32x4 (&acc)[2][2][4][2], const Unit& u, int wr, int wc, int fr, int fq) const {
        const int row0 = u.pm * BM + wr * 64 + fr; const int col0 = u.pn * BM + wc * 32 + 4 * fq;
#pragma unroll
        for (int ai = 0; ai < 2; ++ai)
#pragma unroll
            for (int m = 0; m < 4; ++m) { const size_t off = (size_t)(row0 + ai * HALF + m * 16) * 1024 + col0;
#pragma unroll
                for (int bj = 0; bj < 2; ++bj)
#pragma unroll
                    for (int n = 0; n < 2; ++n) { const f32x4 xv = *(const f32x4*)(X + off + bj * HALF + n * 16);
                        *(f32x4*)(Y + off + bj * HALF + n * 16) = xv * alpha + acc[ai][bj][m][n] * c; } }
    }
};
template <class Epi, class Sched, bool ALIGN_EPI = false, bool SP2 = false>
__device__ __forceinline__ void gemm_phase(PG8_LAS unsigned char* lds, const Gemm g, const Sched& S, const Epi& E) {
    int tid_raw = threadIdx.x; asm volatile("" : "+v"(tid_raw));
    const int tid = tid_raw, wid = __builtin_amdgcn_readfirstlane(tid >> 6), lane = tid & 63, wr = wid >> 2, wc = wid & 3, fr = lane & 15, fq = lane >> 4;
    const int K = g.K, nt = K / BK;
    unsigned voffA[2], voffB[2];
#pragma unroll
    for (int i = 0; i < 2; ++i) { int R, C; stage_rc(tid * 16 + i * 8192, R, C); const int Rb = Epi::PERM ? ((R & ~31) + perm32(R & 31)) : R;
        voffA[i] = (unsigned)(R * K + C) * 2u; voffB[i] = (unsigned)(Rb * K + C) * 2u; }
    const size_t kstep = (size_t)(BK * 2);
    const size_t hstep = (size_t)HALF * K * 2;
    const size_t tstep = 2 * hstep;
    const unsigned ldsw = (unsigned)wid * 1024u;
    const int aoff = lds_byte(wr * 64 + fr, fq * 8), boff = lds_byte(wc * 32 + fr, fq * 8);
#define PG8_SA(b, h) (((b) * 2 + (h)) * HTB)
#define PG8_SB(b, h) ((4 + (b) * 2 + (h)) * HTB)
#define PG8_STAGE(bufoff, gbase, voff) do { _Pragma("unroll") for (int _i = 0; _i < 2; ++_i) \
        __builtin_amdgcn_global_load_lds((const unsigned*)((const char*)(gbase) + (voff)[_i]), (PG8_LAS unsigned*)(lds + (bufoff) + ldsw + _i * 8192), 16, 0, 0); } while (0)
#define PG8_LDA(dst, b, h) do { _Pragma("unroll") for (int m = 0; m < 4; ++m) _Pragma("unroll") for (int k = 0; k < 2; ++k) dst[m][k] = *(const PG8_LAS bf16x8*)(lds + PG8_SA(b, h) + aoff + m * 2048 + k * 1024); } while (0)
#define PG8_LDB(dst, b, h) do { _Pragma("unroll") for (int n = 0; n < 2; ++n) _Pragma("unroll") for (int k = 0; k < 2; ++k) dst[n][k] = *(const PG8_LAS bf16x8*)(lds + PG8_SB(b, h) + boff + n * 2048 + k * 1024); } while (0)
#define PG8_MMA(ai, bj, At, Bt) do { __builtin_amdgcn_s_setprio(1); _Pragma("unroll") for (int m = 0; m < 4; ++m) _Pragma("unroll") for (int n = 0; n < 2; ++n) _Pragma("unroll") for (int k = 0; k < 2; ++k) \
        acc[ai][bj][m][n] = __builtin_amdgcn_mfma_f32_16x16x32_bf16(Bt[n][k], At[m][k], acc[ai][bj][m][n], 0, 0, 0); __builtin_amdgcn_s_setprio(0); } while (0)
#define PG8_WAIT_V(n) asm volatile("s_waitcnt vmcnt(" #n ")" ::: "memory")
#define PG8_WAIT_L(n) asm volatile("s_waitcnt lgkmcnt(" #n ")" ::: "memory")
#define PG8_BAR __builtin_amdgcn_s_barrier()
#define PG8_SCHED __builtin_amdgcn_sched_barrier(0)
    Unit cur, nxt; int ui = 0;
    if (!S.next(0, cur)) return;
    f32x4 acc[2][2][4][2];
#pragma unroll
    for (int a = 0; a < 2; ++a)
#pragma unroll
        for (int b = 0; b < 2; ++b)
#pragma unroll
            for (int m = 0; m < 4; ++m)
#pragma unroll
                for (int n = 0; n < 2; ++n) acc[a][b][m][n] = (f32x4){0.f, 0.f, 0.f, 0.f};
    bf16x8 At[4][2], B0[2][2], B1[2][2];
    const char* cA = (const char*)g.A + (size_t)cur.pm * tstep; const char* cB = (const char*)g.Bt + (size_t)cur.pn * tstep;
    S.a_ready(cur);
    if constexpr (SP2) {
        PG8_STAGE(PG8_SB(0, 0), cB, voffB); PG8_STAGE(PG8_SB(0, 1), cB + hstep, voffB); PG8_STAGE(PG8_SA(0, 0), cA, voffA); PG8_STAGE(PG8_SA(0, 1), cA + hstep, voffA);
        if (wr == 1) PG8_BAR;
        PG8_WAIT_V(2); PG8_BAR;
        PG8_STAGE(PG8_SB(1, 0), cB + kstep, voffB); PG8_STAGE(PG8_SA(1, 0), cA + kstep, voffA); PG8_STAGE(PG8_SB(1, 1), cB + hstep + kstep, voffB);
        PG8_WAIT_V(6); PG8_BAR;
    } else {
        PG8_STAGE(PG8_SB(0, 0), cB, voffB); PG8_STAGE(PG8_SA(0, 0), cA, voffA); PG8_STAGE(PG8_SB(0, 1), cB + hstep, voffB); PG8_STAGE(PG8_SA(0, 1), cA + hstep, voffA);
        if (wr == 1) PG8_BAR;
        PG8_WAIT_V(4); PG8_BAR;
        PG8_STAGE(PG8_SB(1, 0), cB + kstep, voffB); PG8_STAGE(PG8_SA(1, 0), cA + kstep, voffA); PG8_STAGE(PG8_SB(1, 1), cB + hstep + kstep, voffB);
        PG8_WAIT_V(6); PG8_BAR;
    }
    for (;;) {
        const bool has_next = S.next(ui + 1, nxt);
        const char* nA = has_next ? (const char*)g.A + (size_t)nxt.pm * tstep : cA; const char* nB = has_next ? (const char*)g.Bt + (size_t)nxt.pn * tstep : cB;
        for (int t = 0; t < nt; t += 2) {
            const bool last = (t == nt - 2);
            const char* a1 = cA + (size_t)(t + 1) * kstep;
            const char* a2 = last ? nA : cA + (size_t)(t + 2) * kstep; const char* b2 = last ? nB : cB + (size_t)(t + 2) * kstep;
            const char* a3 = a2 + kstep; const char* b3 = b2 + kstep;
            if (last && has_next) S.a_ready(nxt);
            if constexpr (SP2) {
            PG8_LDB(B0, 0, 0); PG8_LDB(B1, 0, 1); PG8_SCHED; PG8_LDA(At, 0, 0); PG8_STAGE(PG8_SA(1, 1), a1 + hstep, voffA);
            PG8_WAIT_V(8); PG8_WAIT_L(0); PG8_BAR; PG8_MMA(0, 0, At, B0); PG8_MMA(0, 1, At, B1); PG8_BAR; PG8_SCHED;
            PG8_LDA(At, 0, 1); PG8_STAGE(PG8_SB(0, 0), b2, voffB); PG8_STAGE(PG8_SB(0, 1), b2 + hstep, voffB); PG8_STAGE(PG8_SA(0, 0), a2, voffA);
            PG8_WAIT_V(8); PG8_WAIT_L(0); PG8_BAR; PG8_MMA(1, 0, At, B0); PG8_MMA(1, 1, At, B1); PG8_BAR; PG8_SCHED;
            PG8_LDB(B0, 1, 0); PG8_LDB(B1, 1, 1); PG8_SCHED; PG8_LDA(At, 1, 0); PG8_STAGE(PG8_SA(0, 1), a2 + hstep, voffA);
            PG8_WAIT_V(8); PG8_WAIT_L(0); PG8_BAR; PG8_MMA(0, 0, At, B0); PG8_MMA(0, 1, At, B1); PG8_BAR; PG8_SCHED;
            PG8_LDA(At, 1, 1); PG8_STAGE(PG8_SB(1, 0), b3, voffB); PG8_STAGE(PG8_SB(1, 1), b3 + hstep, voffB); PG8_STAGE(PG8_SA(1, 0), a3, voffA);
            PG8_WAIT_V(8); PG8_WAIT_L(0); PG8_BAR; PG8_MMA(1, 0, At, B0); PG8_MMA(1, 1, At, B1); PG8_BAR; PG8_SCHED;
            } else {
            PG8_LDB(B0, 0, 0); PG8_SCHED; PG8_LDA(At, 0, 0); PG8_STAGE(PG8_SA(1, 1), a1 + hstep, voffA);
            PG8_WAIT_L(8); PG8_BAR; PG8_WAIT_L(0); PG8_MMA(0, 0, At, B0); PG8_BAR; PG8_SCHED;
            PG8_LDB(B1, 0, 1); PG8_STAGE(PG8_SB(0, 0), b2, voffB);
            PG8_BAR; PG8_WAIT_L(0); PG8_MMA(0, 1, At, B1); PG8_BAR;
            PG8_LDA(At, 0, 1); PG8_STAGE(PG8_SA(0, 0), a2, voffA);
            PG8_BAR; PG8_WAIT_L(0); PG8_MMA(1, 0, At, B0); PG8_BAR; PG8_SCHED;
            PG8_STAGE(PG8_SB(0, 1), b2 + hstep, voffB);
            PG8_WAIT_V(6); PG8_BAR; PG8_MMA(1, 1, At, B1); PG8_BAR;
            PG8_LDB(B0, 1, 0); PG8_SCHED; PG8_LDA(At, 1, 0); PG8_STAGE(PG8_SA(0, 1), a2 + hstep, voffA);
            PG8_WAIT_L(8); PG8_BAR; PG8_WAIT_L(0); PG8_MMA(0, 0, At, B0); PG8_BAR; PG8_SCHED;
            PG8_LDB(B1, 1, 1); PG8_STAGE(PG8_SB(1, 0), b3, voffB);
            PG8_BAR; PG8_WAIT_L(0); PG8_MMA(0, 1, At, B1); PG8_BAR;
            PG8_LDA(At, 1, 1); PG8_STAGE(PG8_SA(1, 0), a3, voffA);
            PG8_BAR; PG8_WAIT_L(0); PG8_MMA(1, 0, At, B0); PG8_BAR; PG8_SCHED;
            PG8_STAGE(PG8_SB(1, 1), b3 + hstep, voffB);
            PG8_WAIT_V(6); PG8_BAR; PG8_MMA(1, 1, At, B1); PG8_BAR;
            }
        }
        if constexpr (ALIGN_EPI) { if (wr == 0) PG8_BAR; }
        if constexpr (!Epi::AFTER_DRAIN) { E(acc, cur, wr, wc, fr, fq); S.done(cur); }
        if (!has_next) break;
#pragma unroll
        for (int a = 0; a < 2; ++a)
#pragma unroll
            for (int b = 0; b < 2; ++b)
#pragma unroll
                for (int m = 0; m < 4; ++m)
#pragma unroll
                    for (int n = 0; n < 2; ++n) acc[a][b][m][n] = (f32x4){0.f, 0.f, 0.f, 0.f};
        cur = nxt; cA = nA; cB = nB; ++ui;
        if constexpr (ALIGN_EPI) { if (wr == 1) PG8_BAR; }
    }
    PG8_WAIT_V(0);
    if constexpr (!ALIGN_EPI) { if (wr == 0) PG8_BAR; }
    PG8_BAR;
    if constexpr (Epi::AFTER_DRAIN) { E.fused(acc, cur, wr, wc, fr, fq, lds, wid, lane); S.done(cur); }
#undef PG8_SA
#undef PG8_SB
#undef PG8_STAGE
#undef PG8_LDA
#undef PG8_LDB
#undef PG8_MMA
#undef PG8_WAIT_V
#undef PG8_WAIT_L
#undef PG8_BAR
#undef PG8_SCHED
}
}
#define LAS __attribute__((address_space(3)))
typedef unsigned short bf16;
typedef float f32x4 __attribute__((ext_vector_type(4)));
typedef unsigned v4u __attribute__((ext_vector_type(4)));
typedef unsigned v2u __attribute__((ext_vector_type(2)));
constexpr int M = 16384, D = 1024, FF = 2816, SEQ = 4096, NB = 4;
constexpr float LN_EPS = 1e-5f;
constexpr float ALPHA = 1.6817928305074290f;
constexpr size_t MiB = 1u << 20;
constexpr size_t WS_CTL = 0;
constexpr size_t WS_WGU = 1 * MiB;
constexpr size_t SZ_WGU = (size_t)5632 * 1024 * 2;
constexpr size_t WS_WD = WS_WGU + 8 * SZ_WGU;
constexpr size_t SZ_WD = (size_t)1024 * 2816 * 2;
constexpr size_t WS_AIN = WS_WD + 8 * SZ_WD;
constexpr size_t SZ_AIN = (size_t)3072 * 1024 * 2;
constexpr size_t SZ_SQ = (size_t)1024 * 1024 * 2;
constexpr size_t WS_AOUT = WS_AIN + 2 * SZ_AIN;
constexpr size_t WS_BIN = WS_AOUT + 2 * SZ_SQ;
constexpr size_t WS_BCOMB = WS_BIN + SZ_SQ;
constexpr size_t WS_CIN = WS_BCOMB + SZ_SQ;
constexpr size_t WS_COUT = WS_CIN + 4 * SZ_SQ;
constexpr size_t WS_XB = WS_COUT + SZ_SQ;
constexpr size_t WS_Y = WS_XB + (size_t)M * D * 2;
constexpr size_t WS_HB = WS_Y + (size_t)M * D * 4;
constexpr size_t WS_MX = WS_HB + (size_t)M * FF * 2;
constexpr size_t WS_END = WS_MX + 290 * MiB;
constexpr size_t MX_QK = 0, MX_VT = 64 * MiB, MX_O = 96 * MiB, MX_KMEAN = 128 * MiB, MX_KN = 129 * MiB;
constexpr size_t MX_U = 0, MX_P = 32 * MiB;
constexpr size_t MX_PROJ = 0, MX_QC = 128 * MiB, MX_KC = 160 * MiB, MX_HT = 192 * MiB  , MX_GATES = 256 * MiB, MX_HN2 = 257 * MiB  ;

constexpr int LDS_BYTES = 147456;

__device__ const unsigned char T5_BUCKET[128] = {0, 1, 2, 3, 4, 5, 6, 7, 8, 9, 10, 11, 12, 13, 14, 15, 16, 16, 16, 17, 17, 18, 18, 18, 19, 19, 19, 20, 20, 20, 20, 21, 21, 21, 21, 22, 22, 22, 22, 22, 23, 23, 23, 23, 23, 23, 24, 24, 24, 24, 24, 24, 25, 25, 25, 25, 25, 25, 25, 26, 26, 26, 26, 26, 26, 26, 26, 27, 27, 27, 27, 27, 27, 27, 27, 27, 27, 28, 28, 28, 28, 28, 28, 28, 28, 28, 28, 29, 29, 29, 29, 29, 29, 29, 29, 29, 29, 29, 29, 30, 30, 30, 30, 30, 30, 30, 30, 30, 30, 30, 30, 30, 30, 31, 31, 31, 31, 31, 31, 31, 31, 31, 31, 31, 31, 31, 31, 31};

__device__ __forceinline__ unsigned f2bf(float f) { unsigned u = __builtin_bit_cast(unsigned, f); return (u + 0x7fffu + ((u >> 16) & 1u)) >> 16; }
__device__ __forceinline__ unsigned pk2(float lo, float hi) { return f2bf(lo) | (f2bf(hi) << 16); }
__device__ __forceinline__ float bf_lo(unsigned w) { return __builtin_bit_cast(float, w << 16); }
__device__ __forceinline__ float bf_hi(unsigned w) { return __builtin_bit_cast(float, w & 0xffff0000u); }
__device__ __forceinline__ float bf1(bf16 v) { return __builtin_bit_cast(float, (unsigned)v << 16); }
__device__ __forceinline__ float wave_sum(float v) {
#pragma unroll
    for (int o = 1; o < 64; o <<= 1) v += __shfl_xor(v, o);
    return v;
}
__device__ __forceinline__ float wave_max(float v) {
#pragma unroll
    for (int o = 1; o < 64; o <<= 1) v = fmaxf(v, __shfl_xor(v, o));
    return v;
}
#define LDS_WAIT() asm volatile("s_waitcnt lgkmcnt(0)" ::: "memory")

struct Args {
    const float* x; const float* rel_bias; const float* ln_g; const float* ln_b; const float* ffn_w_gu; const float* ffn_w_down;
    const float* a_w_in; const float* a_w_out; const float* b_w_in; const float* b_w_group; const float* b_scale; const float* b_w_out;
    const float* c_w_in; const float* c_b_gates; const float* c_conv_w; const float* c_norm_g; const float* c_w_out;
    float* out; unsigned char* ws;
};

__device__ __forceinline__ void transpose_item(const float* W, int ldw, int K, bf16* WT, int k0, int n0, int drow0, LAS float* scr, int lane) {
#pragma unroll 8
    for (int i = 0; i < 32; ++i) { const int kk = 2 * i + (lane >> 5); scr[kk * 33 + (lane & 31)] = W[(size_t)(k0 + kk) * ldw + n0 + (lane & 31)]; }
    LDS_WAIT(); asm volatile("" ::: "memory");
    const int c = lane & 7;
#pragma unroll
    for (int j = 0; j < 4; ++j) { const int n = (lane >> 3) + 8 * j; const LAS float* s = scr + (8 * c) * 33 + n;
        v4u o; o.x = pk2(s[0 * 33], s[1 * 33]); o.y = pk2(s[2 * 33], s[3 * 33]); o.z = pk2(s[4 * 33], s[5 * 33]); o.w = pk2(s[6 * 33], s[7 * 33]);
        *(v4u*)(WT + (size_t)(drow0 + n) * K + k0 + 8 * c) = o; }
    LDS_WAIT(); asm volatile("" ::: "memory");
}
__device__ __forceinline__ void tr_plain(const float* W, int ldw, int K, int ncols, bf16* WT, int r, LAS float* scr, int lane) {
    const int nblk = ncols / 32, kb = r / nblk, nb = r % nblk;
    transpose_item(W, ldw, K, WT, 64 * kb, 32 * nb, 32 * nb, scr, lane);
}

__device__ __forceinline__ void p0_prologue(const Args& a, LAS unsigned char* lds, int gw, int NGW, int wave, int lane) {
    LAS float* scr = (LAS float*)(lds + wave * 16384);
    unsigned char* ws = a.ws;
    constexpr int I_GU = 16 * 176, I_DN = 44 * 32, I_AIN = 16 * 96, I_SQ = 16 * 32, I_CIN = 16 * 128;
    constexpr int NITEMS = 8 * I_GU + 8 * I_DN + 2 * I_AIN + 2 * I_SQ + I_SQ + I_CIN + I_SQ;
    for (int it = gw; it < NITEMS; it += NGW) {
        int r = it;
        if (r < 8 * I_GU) { const int mi = r / I_GU; r -= mi * I_GU; const int kb = r / 176, nb = r % 176, n0 = 32 * nb;
            const int drow0 = (n0 < FF) ? ((n0 >> 7) * 256 + (n0 & 127)) : ((((n0 - FF) >> 7) * 256) + 128 + ((n0 - FF) & 127));
            transpose_item(a.ffn_w_gu + (size_t)mi * 1024 * 5632, 5632, 1024, (bf16*)(ws + WS_WGU + mi * SZ_WGU), 64 * kb, n0, drow0, scr, lane); continue; }
        r -= 8 * I_GU;
        if (r < 8 * I_DN) { const int mi = r / I_DN; r -= mi * I_DN; tr_plain(a.ffn_w_down + (size_t)mi * 2816 * 1024, 1024, 2816, 1024, (bf16*)(ws + WS_WD + mi * SZ_WD), r, scr, lane); continue; }
        r -= 8 * I_DN;
        if (r < 2 * I_AIN) { const int mi = r / I_AIN; r -= mi * I_AIN; tr_plain(a.a_w_in + (size_t)mi * 1024 * 3072, 3072, 1024, 3072, (bf16*)(ws + WS_AIN + mi * SZ_AIN), r, scr, lane); continue; }
        r -= 2 * I_AIN;
        if (r < 2 * I_SQ) { const int mi = r / I_SQ; r -= mi * I_SQ; tr_plain(a.a_w_out + (size_t)mi * 1024 * 1024, 1024, 1024, 1024, (bf16*)(ws + WS_AOUT + mi * SZ_SQ), r, scr, lane); continue; }
        r -= 2 * I_SQ;
        if (r < I_SQ) { tr_plain(a.b_w_in, 1024, 1024, 1024, (bf16*)(ws + WS_BIN), r, scr, lane); continue; }
        r -= I_SQ;
        if (r < I_CIN) { tr_plain(a.c_w_in, 4104, 1024, 4096, (bf16*)(ws + WS_CIN), r, scr, lane); continue; }
        r -= I_CIN;
        tr_plain(a.c_w_out, 1024, 1024, 1024, (bf16*)(ws + WS_COUT), r, scr, lane);
    }
    {
        bf16* WT = (bf16*)(ws + WS_BCOMB);
        const int gt = gw * 64 + lane, NT = NGW * 64;
        for (int o = gt; o < 1024 * 1024; o += NT) {
            const int k = o >> 10, n = o & 1023, g = k >> 8;
            const float* wg = a.b_w_group + (size_t)k * 256; const float* sc = a.b_scale + g * 256; const float* wo = a.b_w_out + (size_t)(g * 256) * 1024 + n;
            float acc = 0.f;
#pragma unroll 8
            for (int d = 0; d < 256; ++d) acc += wg[d] * sc[d] * wo[(size_t)d * 1024];
            WT[(size_t)n * 1024 + k] = (bf16)f2bf(acc);
        }
    }
    {
        bf16* XB = (bf16*)(ws + WS_XB);
        const int gt = gw * 64 + lane, NT = NGW * 64;
        for (int o = gt; o < M * D / 8; o += NT) {
            const f32x4 v0 = ((const f32x4*)a.x)[2 * o], v1 = ((const f32x4*)a.x)[2 * o + 1];
            v4u w; w.x = pk2(v0.x, v0.y); w.y = pk2(v0.z, v0.w); w.z = pk2(v1.x, v1.y); w.w = pk2(v1.z, v1.w);
            ((v4u*)XB)[o] = w;
        }
        if (gw == 0 && lane < 32) ((unsigned*)(ws + WS_MX + MX_KN))[lane] = 0u;
    }
}

__device__ __forceinline__ void ln_phase(const float* Y, const float* g, const float* b, float* X, bf16* XB, int gw, int NGW, int lane) {
    f32x4 gv[4], bv[4];
#pragma unroll
    for (int j = 0; j < 4; ++j) { gv[j] = ((const f32x4*)g)[lane + 64 * j]; bv[j] = ((const f32x4*)b)[lane + 64 * j]; }
    for (int m = gw; m < M; m += NGW) {
        const f32x4* yr = (const f32x4*)(Y + (size_t)m * D) + lane;
        f32x4 v[4]; float s = 0.f;
#pragma unroll
        for (int j = 0; j < 4; ++j) { v[j] = yr[64 * j]; s += (v[j].x + v[j].y) + (v[j].z + v[j].w); }
        const float mean = wave_sum(s) * (1.f / D); float s2 = 0.f;
#pragma unroll
        for (int j = 0; j < 4; ++j) { v[j] = v[j] - mean; s2 += (v[j].x * v[j].x + v[j].y * v[j].y) + (v[j].z * v[j].z + v[j].w * v[j].w); }
        const float rstd = 1.f / sqrtf(wave_sum(s2) * (1.f / D) + LN_EPS);
        f32x4* xo = (f32x4*)(X + (size_t)m * D) + lane; v2u* bo = (v2u*)(XB + (size_t)m * D) + lane;
#pragma unroll
        for (int j = 0; j < 4; ++j) { const f32x4 o = v[j] * rstd * gv[j] + bv[j]; xo[64 * j] = o; v2u w; w.x = pk2(o.x, o.y); w.y = pk2(o.z, o.w); bo[64 * j] = w; }
    }
}
__device__ __forceinline__ void kmean_phase(const bf16* QK, float* KMEAN, unsigned* KN, LAS unsigned char* lds, int tid, int G) {
    LAS float* red = (LAS float*)lds;
    const int wave = tid >> 6, lane = tid & 63;
    for (int u = blockIdx.x; u < 512; u += G) {
        const int h = u & 7, j = (u >> 3) & 15, b = u >> 7;
        const bf16* kb = QK + (size_t)(b * 4096 + j * 256) * 2048 + 1024 + h * 128;
        const int d = tid & 127, rq = tid >> 7;
        float s = 0.f;
        for (int r = rq * 64; r < rq * 64 + 64; ++r) s += bf1(kb[(size_t)r * 2048 + d]);
        red[rq * 128 + d] = s;
        float mx = 0.f;
        for (int r = wave * 32; r < wave * 32 + 32; ++r) { const unsigned w = *(const unsigned*)(kb + (size_t)r * 2048 + 2 * lane); const float a = bf_lo(w), c = bf_hi(w); mx = fmaxf(mx, wave_sum(a * a + c * c)); }
        __syncthreads();
        if (tid < 128) KMEAN[((size_t)(b * 8 + h) * 16 + j) * 128 + tid] = (red[tid] + red[128 + tid] + red[256 + tid] + red[384 + tid]) * (1.f / 256.f);
        if (lane == 0) atomicMax(KN + b * 8 + h, __float_as_uint(mx));
        __syncthreads();
    }
}
#define DOT8(W_, QA_, QB_) (bf_lo((W_).x) * (QA_).x + bf_hi((W_).x) * (QA_).y + bf_lo((W_).y) * (QA_).z + bf_hi((W_).y) * (QA_).w + bf_lo((W_).z) * (QB_).x + bf_hi((W_).z) * (QB_).y + bf_lo((W_).w) * (QB_).z + bf_hi((W_).w) * (QB_).w)
__device__ __forceinline__ void attn_valu_phase(const bf16* QK, const bf16* VT, const float* KMEAN, const float* rel_bias, bf16* O, LAS unsigned char* lds, int gw, int NGW, int wave, int lane) {
    LAS float* qs = (LAS float*)(lds + wave * 8192);
    LAS float* ps = qs + 128;
    const float scale = 0.08838834764831845f, NINF = -__builtin_inff();
    for (int idx = gw; idx < NB * 8 * SEQ; idx += NGW) {
        const int s = idx & 4095, bh = idx >> 12, h = bh & 7, b = bh >> 3, qb = s >> 8; const size_t row = (size_t)b * 4096 + s;
        const unsigned qq = *(const unsigned*)(QK + row * 2048 + h * 128 + 2 * lane);
        const float q0 = bf_lo(qq), q1 = bf_hi(qq);
        qs[2 * lane] = q0; qs[2 * lane + 1] = q1;
        float t0 = NINF, t1 = NINF, t2 = NINF; int i0 = 0, i1 = 1, i2 = 2;
        const float* km = KMEAN + (size_t)(b * 8 + h) * 16 * 128;
        for (int j = 0; j < qb; ++j) { const float g = wave_sum(q0 * km[j * 128 + 2 * lane] + q1 * km[j * 128 + 2 * lane + 1]);
            if (g > t0) { t2 = t1; i2 = i1; t1 = t0; i1 = i0; t0 = g; i0 = j; } else if (g > t1) { t2 = t1; i2 = i1; t1 = g; i1 = j; } else if (g > t2) { t2 = g; i2 = j; } }
        const int nsel = qb < 3 ? qb : 3;
        LDS_WAIT(); asm volatile("" ::: "memory");
        float mx = NINF;
        for (int blk = 0; blk <= nsel; ++blk) {
            const int kb = blk == 0 ? qb : (blk == 1 ? i0 : (blk == 2 ? i1 : i2));
            for (int kk = 0; kk < 4; ++kk) {
                const int key = kb * 256 + kk * 64 + lane;
                const bf16* kr = QK + ((size_t)b * 4096 + key) * 2048 + 1024 + h * 128;
                float dot = 0.f;
#pragma unroll 4
                for (int c = 0; c < 16; ++c) { const v4u w = *(const v4u*)(kr + 8 * c); const f32x4 qa = *(const LAS f32x4*)(qs + 8 * c), qc = *(const LAS f32x4*)(qs + 8 * c + 4); dot += DOT8(w, qa, qc); }
                const int dist = s - key;
                float sc = NINF;
                if (dist >= 0) { const int bucket = dist < 128 ? (int)T5_BUCKET[dist] : 31; sc = dot * scale + rel_bias[bucket * 8 + h]; }
                ps[blk * 256 + kk * 64 + lane] = sc; mx = fmaxf(mx, sc);
            }
        }
        mx = wave_max(mx);
        LDS_WAIT(); asm volatile("" ::: "memory");
        float l = 0.f;
        const int nk = (nsel + 1) * 256;
        for (int i = lane; i < nk; i += 64) { const float p = __expf(ps[i] - mx); ps[i] = p; l += p; }
        l = wave_sum(l);
        LDS_WAIT(); asm volatile("" ::: "memory");
        float o0 = 0.f, o1 = 0.f;
        for (int blk = 0; blk <= nsel; ++blk) {
            const int kb = blk == 0 ? qb : (blk == 1 ? i0 : (blk == 2 ? i1 : i2));
            const bf16* v0p = VT + (size_t)(h * 128 + 2 * lane) * M + (size_t)b * 4096 + kb * 256; const bf16* v1p = v0p + M;
#pragma unroll 4
            for (int k8 = 0; k8 < 32; ++k8) { const v4u a = *(const v4u*)(v0p + 8 * k8), c = *(const v4u*)(v1p + 8 * k8);
                const f32x4 pa = *(const LAS f32x4*)(ps + blk * 256 + 8 * k8), pb = *(const LAS f32x4*)(ps + blk * 256 + 8 * k8 + 4);
                o0 += DOT8(a, pa, pb); o1 += DOT8(c, pa, pb); }
        }
        const float inv = 1.f / l;
        *(unsigned*)(O + row * 1024 + h * 128 + 2 * lane) = pk2(o0 * inv, o1 * inv);
        LDS_WAIT(); asm volatile("" ::: "memory");
    }
}
__device__ __forceinline__ void pool_phase(const bf16* U, bf16* P, int gt, int NT) {
    for (int o = gt; o < M * 128; o += NT) {
        const int row = o >> 7, c8 = (o & 127) * 8, s = row & 4095, g = c8 >> 8, w = 2 << g;
        const int cnt = (s + 1 < w) ? s + 1 : w;
        float a0 = 0, a1 = 0, a2 = 0, a3 = 0, a4 = 0, a5 = 0, a6 = 0, a7 = 0;
        const v4u cur = *(const v4u*)(U + (size_t)row * 1024 + c8);
        for (int i = 0; i < cnt; ++i) { const v4u v = *(const v4u*)(U + (size_t)(row - i) * 1024 + c8);
            a0 += bf_lo(v.x); a1 += bf_hi(v.x); a2 += bf_lo(v.y); a3 += bf_hi(v.y); a4 += bf_lo(v.z); a5 += bf_hi(v.z); a6 += bf_lo(v.w); a7 += bf_hi(v.w); }
        const float ic = 1.f / (float)cnt;
        v4u r; r.x = pk2(a0 * ic - bf_lo(cur.x), a1 * ic - bf_hi(cur.x)); r.y = pk2(a2 * ic - bf_lo(cur.y), a3 * ic - bf_hi(cur.y));
        r.z = pk2(a4 * ic - bf_lo(cur.z), a5 * ic - bf_hi(cur.z)); r.w = pk2(a6 * ic - bf_lo(cur.w), a7 * ic - bf_hi(cur.w));
        *(v4u*)(P + (size_t)row * 1024 + c8) = r;
    }
}
__device__ __forceinline__ void gates_phase(const float* X, const float* c_w_in, const float* c_b_gates, float* GATES, int gw, int NGW, int lane) {
    for (int m = gw; m < M; m += NGW) {
        f32x4 a0 = {0.f, 0.f, 0.f, 0.f}, a1 = {0.f, 0.f, 0.f, 0.f};
#pragma unroll
        for (int j = 0; j < 4; ++j) { const f32x4 xv = ((const f32x4*)(X + (size_t)m * D))[lane + 64 * j]; const int k = (lane + 64 * j) * 4;
#pragma unroll
            for (int e = 0; e < 4; ++e) { const float* wr = c_w_in + (size_t)(k + e) * 4104 + 4096; const f32x4 w0 = *(const f32x4*)wr, w1 = *(const f32x4*)(wr + 4); a0 += w0 * xv[e]; a1 += w1 * xv[e]; } }
        float r0 = wave_sum(a0.x), r1 = wave_sum(a0.y), r2 = wave_sum(a0.z), r3 = wave_sum(a0.w), r4 = wave_sum(a1.x), r5 = wave_sum(a1.y), r6 = wave_sum(a1.z), r7 = wave_sum(a1.w);
        if (lane < 8) { const float v = lane == 0 ? r0 : lane == 1 ? r1 : lane == 2 ? r2 : lane == 3 ? r3 : lane == 4 ? r4 : lane == 5 ? r5 : lane == 6 ? r6 : r7; GATES[(size_t)m * 8 + lane] = v + c_b_gates[lane]; }
    }
}
__device__ __forceinline__ void conv_phase(const bf16* PROJ, const float* conv_w, bf16* QC, bf16* KC, int gt, int NT) {
    for (int o = gt; o < M * 256; o += NT) {
        const int row = o >> 8, c8 = (o & 255) * 8, s = row & 4095;
        f32x4 lo = {0.f, 0.f, 0.f, 0.f}, hi = {0.f, 0.f, 0.f, 0.f};
#pragma unroll
        for (int j = 0; j < 4; ++j) { if (s - 3 + j >= 0) { const v4u v = *(const v4u*)(PROJ + (size_t)(row - 3 + j) * 4096 + c8);
                const f32x4 w0 = *(const f32x4*)(conv_w + j * 2048 + c8), w1 = *(const f32x4*)(conv_w + j * 2048 + c8 + 4);
                lo += w0 * (f32x4){bf_lo(v.x), bf_hi(v.x), bf_lo(v.y), bf_hi(v.y)}; hi += w1 * (f32x4){bf_lo(v.z), bf_hi(v.z), bf_lo(v.w), bf_hi(v.w)}; } }
        const float sc = c8 >= 1024 ? 0.0625f : 1.0f;
        v4u r; r.x = pk2(pg8::silu_f(lo.x) * sc, pg8::silu_f(lo.y) * sc); r.y = pk2(pg8::silu_f(lo.z) * sc, pg8::silu_f(lo.w) * sc);
        r.z = pk2(pg8::silu_f(hi.x) * sc, pg8::silu_f(hi.y) * sc); r.w = pk2(pg8::silu_f(hi.z) * sc, pg8::silu_f(hi.w) * sc);
        if (c8 >= 1024) *(v4u*)(KC + (size_t)row * 1024 + (c8 - 1024)) = r; else *(v4u*)(QC + (size_t)row * 1024 + c8) = r;
    }
}
__device__ __forceinline__ void mlstm_valu_phase(const bf16* QC, const bf16* KC, const bf16* PROJ, const float* GATES, float* HT, LAS unsigned char* lds, int tid, int G) {
    LAS float* Cst = (LAS float*)lds;
    LAS float* nst = Cst + 256 * 33;
    LAS bf16* qs = (LAS bf16*)(nst + 256);
    LAS bf16* ks = qs + 64 * 264;
    LAS float* vsm = (LAS float*)(ks + 64 * 264);
    LAS float* Wm = vsm + 64 * 33;
    LAS float* sv = Wm + 64 * 65;
    for (int u = blockIdx.x; u < 128; u += G) {
        const int vsl = u & 7, h = (u >> 3) & 3, b = u >> 5;
        for (int i = tid; i < 256 * 33; i += 512) Cst[i] = 0.f;
        if (tid < 256) nst[tid] = 0.f;
        if (tid == 0) sv[320] = 0.f;
        __syncthreads();
        for (int c = 0; c < 64; ++c) {
            const size_t row0 = (size_t)b * 4096 + c * 64;
            for (int i = tid; i < 2048; i += 512) { const int r = i >> 5, c8 = (i & 31) * 8;
                *(LAS v4u*)(qs + r * 264 + c8) = *(const v4u*)(QC + (row0 + r) * 1024 + h * 256 + c8);
                *(LAS v4u*)(ks + r * 264 + c8) = *(const v4u*)(KC + (row0 + r) * 1024 + h * 256 + c8); }
            { const int r = tid >> 3, c4 = (tid & 7) * 4; const v2u w = *(const v2u*)(PROJ + (row0 + r) * 4096 + 2048 + h * 256 + vsl * 32 + c4);
              vsm[r * 33 + c4] = bf_lo(w.x); vsm[r * 33 + c4 + 1] = bf_hi(w.x); vsm[r * 33 + c4 + 2] = bf_lo(w.y); vsm[r * 33 + c4 + 3] = bf_hi(w.y); }
            if (tid < 64) {
                const float ig = GATES[(row0 + tid) * 8 + h], fp = GATES[(row0 + tid) * 8 + 4 + h];
                const float lf = fminf(fp, 0.f) - log1pf(__expf(-fabsf(fp)));
                float bsum = lf;
#pragma unroll
                for (int o = 1; o < 64; o <<= 1) { const float t = __shfl_up(bsum, o); if (tid >= o) bsum += t; }
                const float av = ig - bsum;
                float cm = av;
#pragma unroll
                for (int o = 1; o < 64; o <<= 1) { const float t = __shfl_up(cm, o); if (tid >= o) cm = fmaxf(cm, t); }
                const float mp = sv[320];
                const float m_inter = bsum + mp, mt = fmaxf(m_inter, bsum + cm);
                const float blast = __shfl(bsum, 63);
                const float gs = blast - bsum + ig;
                const float mnew = fmaxf(blast + mp, wave_max(gs));
                sv[tid] = bsum; sv[64 + tid] = av; sv[128 + tid] = mt; sv[192 + tid] = __expf(m_inter - mt); sv[256 + tid] = __expf(gs - mnew);
                if (tid == 0) { sv[321] = __expf(blast + mp - mnew); sv[322] = mnew; }
            }
            __syncthreads();
            { const int t = tid >> 3, sg = tid & 7; const float bt = sv[t], mt = sv[128 + t];
              float d0 = 0, d1 = 0, d2 = 0, d3 = 0, d4 = 0, d5 = 0, d6 = 0, d7 = 0;
              if (sg * 8 <= t) {
                  for (int dk8 = 0; dk8 < 32; ++dk8) { const v4u qv = *(const LAS v4u*)(qs + t * 264 + dk8 * 8);
                      const f32x4 qa = {bf_lo(qv.x), bf_hi(qv.x), bf_lo(qv.y), bf_hi(qv.y)}, qc = {bf_lo(qv.z), bf_hi(qv.z), bf_lo(qv.w), bf_hi(qv.w)};
                      const LAS bf16* kp = ks + (sg * 8) * 264 + dk8 * 8;
                      { const v4u w = *(const LAS v4u*)(kp + 0 * 264); d0 += DOT8(w, qa, qc); } { const v4u w = *(const LAS v4u*)(kp + 1 * 264); d1 += DOT8(w, qa, qc); }
                      { const v4u w = *(const LAS v4u*)(kp + 2 * 264); d2 += DOT8(w, qa, qc); } { const v4u w = *(const LAS v4u*)(kp + 3 * 264); d3 += DOT8(w, qa, qc); }
                      { const v4u w = *(const LAS v4u*)(kp + 4 * 264); d4 += DOT8(w, qa, qc); } { const v4u w = *(const LAS v4u*)(kp + 5 * 264); d5 += DOT8(w, qa, qc); }
                      { const v4u w = *(const LAS v4u*)(kp + 6 * 264); d6 += DOT8(w, qa, qc); } { const v4u w = *(const LAS v4u*)(kp + 7 * 264); d7 += DOT8(w, qa, qc); } }
              }
#define WSTORE(e, dv) { const int s_ = sg * 8 + e; Wm[t * 65 + s_] = (s_ <= t) ? __expf(bt + sv[64 + s_] - mt) * dv : 0.f; }
              WSTORE(0, d0) WSTORE(1, d1) WSTORE(2, d2) WSTORE(3, d3) WSTORE(4, d4) WSTORE(5, d5) WSTORE(6, d6) WSTORE(7, d7)
#undef WSTORE
            }
            __syncthreads();
            { const int t = tid >> 3, vg = tid & 7; const float sint = sv[192 + t], mt = sv[128 + t];
              f32x4 inter = {0.f, 0.f, 0.f, 0.f}, intra = {0.f, 0.f, 0.f, 0.f}; float qn = 0.f, wsum = 0.f;
              for (int dk = 0; dk < 256; ++dk) { const float qv = bf1(qs[t * 264 + dk]); qn += qv * nst[dk]; const LAS float* cp = Cst + dk * 33 + vg * 4; inter += (f32x4){cp[0], cp[1], cp[2], cp[3]} * qv; }
              for (int s = 0; s <= t; ++s) { const float w = Wm[t * 65 + s]; wsum += w; const LAS float* vp = vsm + s * 33 + vg * 4; intra += (f32x4){vp[0], vp[1], vp[2], vp[3]} * w; }
              const float den = sint * qn + wsum; const float dd = 1.f / fmaxf(fabsf(den), __expf(-mt));
              *(f32x4*)(HT + (row0 + t) * 1024 + h * 256 + vsl * 32 + vg * 4) = (inter * sint + intra) * dd; }
            __syncthreads();
            { const int dk = tid >> 1, hf = tid & 1; const float decay = sv[321];
              f32x4 c0 = {0.f, 0.f, 0.f, 0.f}, c1 = c0, c2 = c0, c3 = c0; float nacc = 0.f;
              for (int s = 0; s < 64; ++s) { const float kw = bf1(ks[s * 264 + dk]) * sv[256 + s]; nacc += kw; const LAS float* vp = vsm + s * 33 + hf * 16;
                  c0 += (f32x4){vp[0], vp[1], vp[2], vp[3]} * kw; c1 += (f32x4){vp[4], vp[5], vp[6], vp[7]} * kw; c2 += (f32x4){vp[8], vp[9], vp[10], vp[11]} * kw; c3 += (f32x4){vp[12], vp[13], vp[14], vp[15]} * kw; }
              LAS float* cp = Cst + dk * 33 + hf * 16;
#pragma unroll
              for (int e = 0; e < 4; ++e) { cp[e] = decay * cp[e] + c0[e]; cp[4 + e] = decay * cp[4 + e] + c1[e]; cp[8 + e] = decay * cp[8 + e] + c2[e]; cp[12 + e] = decay * cp[12 + e] + c3[e]; }
              if (hf == 0) nst[dk] = decay * nst[dk] + nacc;
              if (tid == 0) sv[320] = sv[322]; }
            __syncthreads();
        }
    }
}
__device__ __forceinline__ void headnorm_phase(const float* HT, const bf16* PROJ, const float* norm_g, bf16* HN, int gw, int NGW, int lane) {
    for (int m = gw; m < M; m += NGW) {
#pragma unroll
        for (int hh = 0; hh < 4; ++hh) { const int idx = hh * 256 + lane * 4;
            const f32x4 ht = *(const f32x4*)(HT + (size_t)m * 1024 + idx); const v2u ow = *(const v2u*)(PROJ + (size_t)m * 4096 + 3072 + idx);
            const f32x4 op = {bf_lo(ow.x), bf_hi(ow.x), bf_lo(ow.y), bf_hi(ow.y)};
            f32x4 hc;
#pragma unroll
            for (int e = 0; e < 4; ++e) hc[e] = ht[e] / (1.f + __expf(-op[e]));
            const float mu = wave_sum((hc.x + hc.y) + (hc.z + hc.w)) * (1.f / 256.f);
            hc = hc - mu;
            const float var = wave_sum((hc.x * hc.x + hc.y * hc.y) + (hc.z * hc.z + hc.w * hc.w)) * (1.f / 256.f);
            const float rstd = 1.f / sqrtf(var + LN_EPS);
            const f32x4 ng = *(const f32x4*)(norm_g + idx);
            const f32x4 o = hc * rstd * ng;
            v2u w; w.x = pk2(o.x, o.y); w.y = pk2(o.z, o.w);
            *(v2u*)(HN + (size_t)m * 1024 + idx) = w; }
    }
}
__global__ void __launch_bounds__(512, 2) fwd_megakernel(Args a) {
    extern __shared__ __attribute__((aligned(16))) unsigned char lds_raw[];
    cg::grid_group grid = cg::this_grid();
    LAS unsigned char* lds = (LAS unsigned char*)lds_raw;
    const int G = gridDim.x, bx = blockIdx.x, NGW = G * 8, NT = G * 512;
#define LAUNDER_TID() int tid = threadIdx.x; asm volatile("" : "+v"(tid)); const int lane = tid & 63, wave = __builtin_amdgcn_readfirstlane(tid >> 6), gw = bx * 8 + wave, gt = bx * 512 + tid; (void)lane; (void)gw; (void)gt;
    unsigned char* ws = a.ws;
    bf16* XB = (bf16*)(ws + WS_XB); float* Y = (float*)(ws + WS_Y); bf16* HB = (bf16*)(ws + WS_HB); unsigned char* mx = ws + WS_MX;
    float* X = a.out;

    { LAUNDER_TID(); p0_prologue(a, lds, gw, NGW, wave, lane); }
    grid.sync();

#pragma unroll 1
    for (int st = 0; st < 12; ++st) {
        LAUNDER_TID();
        const int layer = st / 3, sub = st - layer * 3;
        const float* Xin = (st == 0) ? a.x : X;
        const bf16* Aop; const bf16* Bt; int K; float cmul;
        if (sub != 1) {
            const int fi = layer * 2 + (sub == 2 ? 1 : 0);
            { pg8::Gemm g{XB, (const bf16*)(ws + WS_WGU + fi * SZ_WGU), M, 2 * FF, D}; pg8::StaticOrder S; S.init(M, 2 * FF, G, bx);
              pg8::EpiSwiglu E{HB, FF};
              pg8::gemm_phase<pg8::EpiSwiglu, pg8::StaticOrder, true, true>(lds, g, S, E); }
            grid.sync();
            Aop = HB; Bt = (const bf16*)(ws + WS_WD + fi * SZ_WD); K = FF; cmul = 0.5f;
        } else {
            const int kind = layer % 3, j = layer / 3;
            if (kind == 0) {
                bf16* QK = (bf16*)(mx + MX_QK); bf16* VT = (bf16*)(mx + MX_VT); bf16* O = (bf16*)(mx + MX_O); float* KMEAN = (float*)(mx + MX_KMEAN); unsigned* KN = (unsigned*)(mx + MX_KN);
                const bf16* Win = (const bf16*)(ws + WS_AIN + j * SZ_AIN);
                { pg8::Gemm g{XB, Win, M, 2048, D}; pg8::StaticOrder S; S.init(M, 2048, G, bx); pg8::EpiBf16 E{QK, 2048};
                  pg8::gemm_phase<pg8::EpiBf16, pg8::StaticOrder, true, true>(lds, g, S, E); }
                { pg8::Gemm g{Win + (size_t)2048 * 1024, XB, 1024, M, D}; pg8::StaticOrder S; S.init(1024, M, G, bx); pg8::EpiBf16 E{VT, M};
                  pg8::gemm_phase<pg8::EpiBf16, pg8::StaticOrder, true, true>(lds, g, S, E); }
                grid.sync();
                kmean_phase(QK, KMEAN, KN, lds, tid, G);
                grid.sync();
                attn_valu_phase(QK, VT, KMEAN, a.rel_bias, O, lds, gw, NGW, wave, lane);
                grid.sync();
                Aop = O; Bt = (const bf16*)(ws + WS_AOUT + j * SZ_SQ); K = D; cmul = 1.0f;
            } else if (kind == 1) {
                bf16* U = (bf16*)(mx + MX_U); bf16* P = (bf16*)(mx + MX_P);
                { pg8::Gemm g{XB, (const bf16*)(ws + WS_BIN), M, D, D}; pg8::StaticOrder S; S.init(M, D, G, bx); pg8::EpiBf16 E{U, D};
                  pg8::gemm_phase<pg8::EpiBf16, pg8::StaticOrder, true, true>(lds, g, S, E); }
                grid.sync();
                pool_phase(U, P, gt, NT);
                grid.sync();
                Aop = P; Bt = (const bf16*)(ws + WS_BCOMB); K = D; cmul = 1.0f;
            } else {
                bf16* PROJ = (bf16*)(mx + MX_PROJ); bf16* QC = (bf16*)(mx + MX_QC); bf16* KC = (bf16*)(mx + MX_KC); float* HT = (float*)(mx + MX_HT); float* GATES = (float*)(mx + MX_GATES); bf16* HN = (bf16*)(mx + MX_HN2);
                { pg8::Gemm g{XB, (const bf16*)(ws + WS_CIN), M, 4096, D}; pg8::StaticOrder S; S.init(M, 4096, G, bx); pg8::EpiBf16 E{PROJ, 4096};
                  pg8::gemm_phase<pg8::EpiBf16, pg8::StaticOrder, true, true>(lds, g, S, E); }
                gates_phase(Xin, a.c_w_in, a.c_b_gates, GATES, gw, NGW, lane);
                grid.sync();
                conv_phase(PROJ, a.c_conv_w, QC, KC, gt, NT);
                grid.sync();
                mlstm_valu_phase(QC, KC, PROJ, GATES, HT, lds, tid, G);
                grid.sync();
                headnorm_phase(HT, PROJ, a.c_norm_g, HN, gw, NGW, lane);
                grid.sync();
                Aop = HN; Bt = (const bf16*)(ws + WS_COUT); K = D; cmul = 1.0f;
            }
        }
        { pg8::Gemm g{Aop, Bt, M, D, K}; pg8::StaticOrder S; S.init(M, D, G, bx); pg8::EpiPreLN E{Xin, Y, ALPHA, cmul};
          pg8::gemm_phase<pg8::EpiPreLN, pg8::StaticOrder, true, true>(lds, g, S, E); }
        grid.sync();
        ln_phase(Y, a.ln_g + (size_t)st * D, a.ln_b + (size_t)st * D, X, XB, gw, NGW, lane);
        grid.sync();
    }
}

extern "C" void kernel_launch(void* const* d_in, const int* in_sizes, int n_in, void* d_out, int out_size, void* d_ws, size_t ws_size, hipStream_t stream) {
    static int grid = 0;
    if (grid == 0) {
        if (n_in != 17 || out_size != M * D || ws_size < WS_END) { fprintf(stderr, "kernel_launch: unexpected shapes (n_in %d out %d ws %zu need %zu)\n", n_in, out_size, ws_size, (size_t)WS_END); grid = -1; return; }
        int dev = 0, cus = 0, per_cu = 0;
        (void)hipGetDevice(&dev); (void)hipDeviceGetAttribute(&cus, hipDeviceAttributeMultiprocessorCount, dev);
        if (hipFuncSetAttribute((const void*)fwd_megakernel, hipFuncAttributeMaxDynamicSharedMemorySize, LDS_BYTES) != hipSuccess) { fprintf(stderr, "kernel_launch: hipFuncSetAttribute failed\n"); grid = -1; return; }
        if (hipOccupancyMaxActiveBlocksPerMultiprocessor(&per_cu, (const void*)fwd_megakernel, 512, LDS_BYTES) != hipSuccess || per_cu < 1) { fprintf(stderr, "kernel_launch: occupancy query gives %d\n", per_cu); per_cu = 1; }
        (void)hipGetLastError();
        grid = cus * 1;
    }
    if (grid < 0) return;
    Args a{};
    a.x = (const float*)d_in[0]; a.rel_bias = (const float*)d_in[1]; a.ln_g = (const float*)d_in[2]; a.ln_b = (const float*)d_in[3];
    a.ffn_w_gu = (const float*)d_in[4]; a.ffn_w_down = (const float*)d_in[5]; a.a_w_in = (const float*)d_in[6]; a.a_w_out = (const float*)d_in[7];
    a.b_w_in = (const float*)d_in[8]; a.b_w_group = (const float*)d_in[9]; a.b_scale = (const float*)d_in[10]; a.b_w_out = (const float*)d_in[11];
    a.c_w_in = (const float*)d_in[12]; a.c_b_gates = (const float*)d_in[13]; a.c_conv_w = (const float*)d_in[14]; a.c_norm_g = (const float*)d_in[15]; a.c_w_out = (const float*)d_in[16];
    a.out = (float*)d_out; a.ws = (unsigned char*)d_ws;
    void* args[] = {&a};
    hipError_t e = hipLaunchCooperativeKernel((const void*)fwd_megakernel, dim3(grid), dim3(512), args, LDS_BYTES, stream);
    if (e != hipSuccess) fprintf(stderr, "kernel_launch: cooperative launch failed: %s (grid %d)\n", hipGetErrorString(e), grid);
}
```

```cpp
#include <hip/hip_runtime.h>
#include <hip/hip_cooperative_groups.h>
#include <cstdio>
#include <cstdint>
namespace cg = cooperative_groups;
namespace pg8 {
#define PG8_LAS __attribute__((address_space(3)))
typedef unsigned short bf16_t;
typedef short bf16x8 __attribute__((ext_vector_type(8)));
typedef float f32x4 __attribute__((ext_vector_type(4)));
typedef unsigned u32x4 __attribute__((ext_vector_type(4)));
constexpr int BM = 256, BK = 64, HALF = 128, HTB = HALF * BK * 2  , STAGE_BYTES = 8 * HTB, NXCD = 8, WGM = 8;

__host__ __device__ __forceinline__ int lds_byte(int r, int c) { const int st = (r >> 4) * 2 + (c >> 5), rr = r & 15, cc = c & 31, ob = rr * 64 + cc * 2; return st * 1024 + (ob ^ (((ob >> 9) & 1) << 5)); }
__host__ __device__ __forceinline__ void stage_rc(int b, int& R, int& C) { const int st = b / 1024, sb = b % 1024, swz = sb ^ (((sb >> 9) & 1) << 5); R = (st >> 1) * 16 + swz / 64; C = (st & 1) * 32 + (swz % 64) / 2; }
__host__ __device__ __forceinline__ int perm32(int rho) { const int n = rho >> 4, i = rho & 15; return 8 * (i >> 2) + 4 * n + (i & 3); }

struct Unit { int pm, pn; };
struct Gemm { const bf16_t* A; const bf16_t* Bt; int M, N, K; };

struct StaticOrder {
    int nM, nN, nwg, G, c;
    __host__ __device__ void init(int M, int N, int G_, int c_) { nM = M / BM; nN = N / BM; nwg = nM * nN; G = G_; c = c_; }
    __host__ __device__ bool next(int i, Unit& u) const {
        const long L = (long)i * G + c; if (L >= nwg) return false;
        int wgid = (int)L; { const int q = nwg / NXCD, r = nwg % NXCD, xcd = wgid % NXCD, off = wgid / NXCD; wgid = (xcd < r ? xcd * (q + 1) : r * (q + 1) + (xcd - r) * q) + off; }
        const int nig = WGM * nN, gid = wgid / nig, fm = gid * WGM, gsz = (nM - fm) < WGM ? (nM - fm) : WGM;
        u.pm = fm + ((wgid % nig) % gsz); u.pn = (wgid % nig) / gsz; return true;
    }
    __device__ __forceinline__ void a_ready(const Unit&) const {}
    __device__ __forceinline__ void done(const Unit&) const {}
};

__device__ __forceinline__ unsigned cvt_pk_bf16(float lo, float hi) { unsigned r; asm volatile("v_cvt_pk_bf16_f32 %0, %1, %2" : "=v"(r) : "v"(lo), "v"(hi)); return r; }
struct EpiBf16 {
    static constexpr bool PERM = true, AFTER_DRAIN = false;
    bf16_t* O; int ldc;
    __device__ __forceinline__ void operator()(const f32x4 (&acc)[2][2][4][2], const Unit& u, int wr, int wc, int fr, int fq) const {
        const int row0 = u.pm * BM + wr * 64 + fr; const int col0 = u.pn * BM + wc * 32 + 8 * fq;
#pragma unroll
        for (int ai = 0; ai < 2; ++ai)
#pragma unroll
            for (int m = 0; m < 4; ++m) { bf16_t* rowp = O + (size_t)(row0 + ai * HALF + m * 16) * ldc + col0;
#pragma unroll
                for (int bj = 0; bj < 2; ++bj) { const f32x4 v0 = acc[ai][bj][m][0], v1 = acc[ai][bj][m][1];
                    u32x4 w; w.x = cvt_pk_bf16(v0[0], v0[1]); w.y = cvt_pk_bf16(v0[2], v0[3]); w.z = cvt_pk_bf16(v1[0], v1[1]); w.w = cvt_pk_bf16(v1[2], v1[3]);
                    *(u32x4*)(rowp + bj * HALF) = w; } }
    }
};
__device__ __forceinline__ float silu_f(float g) { return g * __builtin_amdgcn_rcpf(1.0f + __builtin_amdgcn_exp2f(-1.44269504089f * g)); }
struct EpiSwiglu {
    static constexpr bool PERM = true, AFTER_DRAIN = false;
    bf16_t* O; int ldc;
    __device__ __forceinline__ void operator()(const f32x4 (&acc)[2][2][4][2], const Unit& u, int wr, int wc, int fr, int fq) const {
        const int row0 = u.pm * BM + wr * 64 + fr; const int col0 = u.pn * HALF + wc * 32 + 8 * fq;
#pragma unroll
        for (int ai = 0; ai < 2; ++ai)
#pragma unroll
            for (int m = 0; m < 4; ++m) { bf16_t* rowp = O + (size_t)(row0 + ai * HALF + m * 16) * ldc + col0;
                const f32x4 g0 = acc[ai][0][m][0], g1 = acc[ai][0][m][1], u0 = acc[ai][1][m][0], u1 = acc[ai][1][m][1];
                u32x4 w;
                w.x = cvt_pk_bf16(silu_f(g0[0]) * u0[0], silu_f(g0[1]) * u0[1]); w.y = cvt_pk_bf16(silu_f(g0[2]) * u0[2], silu_f(g0[3]) * u0[3]);
                w.z = cvt_pk_bf16(silu_f(g1[0]) * u1[0], silu_f(g1[1]) * u1[1]); w.w = cvt_pk_bf16(silu_f(g1[2]) * u1[2], silu_f(g1[3]) * u1[3]);
                *(u32x4*)rowp = w; }
    }
};
struct EpiPreLN {
    static constexpr bool PERM = false, AFTER_DRAIN = false;
    const float* X; float* Y; float alpha, c;
    __device__ __forceinline__ void operator()(const f32x4 (&acc)[2][2][4][2], const Unit& u, int wr, int wc, int fr, int fq) const {
        const int row0 = u.pm * BM + wr * 64 + fr; const int col0 = u.pn * BM + wc * 32 + 4 * fq;
#pragma unroll
        for (int ai = 0; ai < 2; ++ai)
#pragma unroll
            for (int m = 0; m < 4; ++m) { const size_t off = (size_t)(row0 + ai * HALF + m * 16) * 1024 + col0;
#pragma unroll
                for (int bj = 0; bj < 2; ++bj)
#pragma unroll
                    for (int n = 0; n < 2; ++n) { const f32x4 xv = *(const f32x4*)(X + off + bj * HALF + n * 16);
                        *(f32x4*)(Y + off + bj * HALF + n * 16) = xv * alpha + acc[ai][bj][m][n] * c; } }
    }
};
template <class Epi, class Sched, bool ALIGN_EPI = false, bool SP2 = false>
__device__ __forceinline__ void gemm_phase(PG8_LAS unsigned char* lds, const Gemm g, const Sched& S, const Epi& E) {
    int tid_raw = threadIdx.x; asm volatile("" : "+v"(tid_raw));
    const int tid = tid_raw, wid = __builtin_amdgcn_readfirstlane(tid >> 6), lane = tid & 63, wr = wid >> 2, wc = wid & 3, fr = lane & 15, fq = lane >> 4;
    const int K = g.K, nt = K / BK;
    unsigned voffA[2], voffB[2];
#pragma unroll
    for (int i = 0; i < 2; ++i) { int R, C; stage_rc(tid * 16 + i * 8192, R, C); const int Rb = Epi::PERM ? ((R & ~31) + perm32(R & 31)) : R;
        voffA[i] = (unsigned)(R * K + C) * 2u; voffB[i] = (unsigned)(Rb * K + C) * 2u; }
    const size_t kstep = (size_t)(BK * 2);
    const size_t hstep = (size_t)HALF * K * 2;
    const size_t tstep = 2 * hstep;
    const unsigned ldsw = (unsigned)wid * 1024u;
    const int aoff = lds_byte(wr * 64 + fr, fq * 8), boff = lds_byte(wc * 32 + fr, fq * 8);
#define PG8_SA(b, h) (((b) * 2 + (h)) * HTB)
#define PG8_SB(b, h) ((4 + (b) * 2 + (h)) * HTB)
#define PG8_STAGE(bufoff, gbase, voff) do { _Pragma("unroll") for (int _i = 0; _i < 2; ++_i) \
        __builtin_amdgcn_global_load_lds((const unsigned*)((const char*)(gbase) + (voff)[_i]), (PG8_LAS unsigned*)(lds + (bufoff) + ldsw + _i * 8192), 16, 0, 0); } while (0)
#define PG8_LDA(dst, b, h) do { _Pragma("unroll") for (int m = 0; m < 4; ++m) _Pragma("unroll") for (int k = 0; k < 2; ++k) dst[m][k] = *(const PG8_LAS bf16x8*)(lds + PG8_SA(b, h) + aoff + m * 2048 + k * 1024); } while (0)
#define PG8_LDB(dst, b, h) do { _Pragma("unroll") for (int n = 0; n < 2; ++n) _Pragma("unroll") for (int k = 0; k < 2; ++k) dst[n][k] = *(const PG8_LAS bf16x8*)(lds + PG8_SB(b, h) + boff + n * 2048 + k * 1024); } while (0)
#define PG8_MMA(ai, bj, At, Bt) do { __builtin_amdgcn_s_setprio(1); _Pragma("unroll") for (int m = 0; m < 4; ++m) _Pragma("unroll") for (int n = 0; n < 2; ++n) _Pragma("unroll") for (int k = 0; k < 2; ++k) \
        acc[ai][bj][m][n] = __builtin_amdgcn_mfma_f32_16x16x32_bf16(Bt[n][k], At[m][k], acc[ai][bj][m][n], 0, 0, 0); __builtin_amdgcn_s_setprio(0); } while (0)
#define PG8_WAIT_V(n) asm volatile("s_waitcnt vmcnt(" #n ")" ::: "memory")
#define PG8_WAIT_L(n) asm volatile("s_waitcnt lgkmcnt(" #n ")" ::: "memory")
#define PG8_BAR __builtin_amdgcn_s_barrier()
#define PG8_SCHED __builtin_amdgcn_sched_barrier(0)
    Unit cur, nxt; int ui = 0;
    if (!S.next(0, cur)) return;
    f32x4 acc[2][2][4][2];
#pragma unroll
    for (int a = 0; a < 2; ++a)
#pragma unroll
        for (int b = 0; b < 2; ++b)
#pragma unroll
            for (int m = 0; m < 4; ++m)
#pragma unroll
                for (int n = 0; n < 2; ++n) acc[a][b][m][n] = (f32x4){0.f, 0.f, 0.f, 0.f};
    bf16x8 At[4][2], B0[2][2], B1[2][2];
    const char* cA = (const char*)g.A + (size_t)cur.pm * tstep; const char* cB = (const char*)g.Bt + (size_t)cur.pn * tstep;
    S.a_ready(cur);
    if constexpr (SP2) {
        PG8_STAGE(PG8_SB(0, 0), cB, voffB); PG8_STAGE(PG8_SB(0, 1), cB + hstep, voffB); PG8_STAGE(PG8_SA(0, 0), cA, voffA); PG8_STAGE(PG8_SA(0, 1), cA + hstep, voffA);
        if (wr == 1) PG8_BAR;
        PG8_WAIT_V(2); PG8_BAR;
        PG8_STAGE(PG8_SB(1, 0), cB + kstep, voffB); PG8_STAGE(PG8_SA(1, 0), cA + kstep, voffA); PG8_STAGE(PG8_SB(1, 1), cB + hstep + kstep, voffB);
        PG8_WAIT_V(6); PG8_BAR;
    } else {
        PG8_STAGE(PG8_SB(0, 0), cB, voffB); PG8_STAGE(PG8_SA(0, 0), cA, voffA); PG8_STAGE(PG8_SB(0, 1), cB + hstep, voffB); PG8_STAGE(PG8_SA(0, 1), cA + hstep, voffA);
        if (wr == 1) PG8_BAR;
        PG8_WAIT_V(4); PG8_BAR;
        PG8_STAGE(PG8_SB(1, 0), cB + kstep, voffB); PG8_STAGE(PG8_SA(1, 0), cA + kstep, voffA); PG8_STAGE(PG8_SB(1, 1), cB + hstep + kstep, voffB);
        PG8_WAIT_V(6); PG8_BAR;
    }
    for (;;) {
        const bool has_next = S.next(ui + 1, nxt);
        const char* nA = has_next ? (const char*)g.A + (size_t)nxt.pm * tstep : cA; const char* nB = has_next ? (const char*)g.Bt + (size_t)nxt.pn * tstep : cB;
        for (int t = 0; t < nt; t += 2) {
            const bool last = (t == nt - 2);
            const char* a1 = cA + (size_t)(t + 1) * kstep;
            const char* a2 = last ? nA : cA + (size_t)(t + 2) * kstep; const char* b2 = last ? nB : cB + (size_t)(t + 2) * kstep;
            const char* a3 = a2 + kstep; const char* b3 = b2 + kstep;
            if (last && has_next) S.a_ready(nxt);
            if constexpr (SP2) {
            PG8_LDB(B0, 0, 0); PG8_LDB(B1, 0, 1); PG8_SCHED; PG8_LDA(At, 0, 0); PG8_STAGE(PG8_SA(1, 1), a1 + hstep, voffA);
            PG8_WAIT_V(8); PG8_WAIT_L(0); PG8_BAR; PG8_MMA(0, 0, At, B0); PG8_MMA(0, 1, At, B1); PG8_BAR; PG8_SCHED;
            PG8_LDA(At, 0, 1); PG8_STAGE(PG8_SB(0, 0), b2, voffB); PG8_STAGE(PG8_SB(0, 1), b2 + hstep, voffB); PG8_STAGE(PG8_SA(0, 0), a2, voffA);
            PG8_WAIT_V(8); PG8_WAIT_L(0); PG8_BAR; PG8_MMA(1, 0, At, B0); PG8_MMA(1, 1, At, B1); PG8_BAR; PG8_SCHED;
            PG8_LDB(B0, 1, 0); PG8_LDB(B1, 1, 1); PG8_SCHED; PG8_LDA(At, 1, 0); PG8_STAGE(PG8_SA(0, 1), a2 + hstep, voffA);
            PG8_WAIT_V(8); PG8_WAIT_L(0); PG8_BAR; PG8_MMA(0, 0, At, B0); PG8_MMA(0, 1, At, B1); PG8_BAR; PG8_SCHED;
            PG8_LDA(At, 1, 1); PG8_STAGE(PG8_SB(1, 0), b3, voffB); PG8_STAGE(PG8_SB(1, 1), b3 + hstep, voffB); PG8_STAGE(PG8_SA(1, 0), a3, voffA);
            PG8_WAIT_V(8); PG8_WAIT_L(0); PG8_BAR; PG8_MMA(1, 0, At, B0); PG8_MMA(1, 1, At, B1); PG8_BAR; PG8_SCHED;
            } else {
            PG8_LDB(B0, 0, 0); PG8_SCHED; PG8_LDA(At, 0, 0); PG8_STAGE(PG8_SA(1, 1), a1 + hstep, voffA);
            PG8_WAIT_L(8); PG8_BAR; PG8_WAIT_L(0); PG8_MMA(0, 0, At, B0); PG8_BAR; PG8_SCHED;
            PG8_LDB(B1, 0, 1); PG8_STAGE(PG8_SB(0, 0), b2, voffB);
            PG8_BAR; PG8_WAIT_L(0); PG8_MMA(0, 1, At, B1); PG8_BAR;
            PG8_LDA(At, 0, 1); PG8_STAGE(PG8_SA(0, 0), a2, voffA);
            PG8_BAR; PG8_WAIT_L(0); PG8_MMA(1, 0, At, B0); PG8_BAR; PG8_SCHED;
            PG8_STAGE(PG8_SB(0, 1), b2 + hstep, voffB);
            PG8_WAIT_V(6); PG8_BAR; PG8_MMA(1, 1, At, B1); PG8_BAR;
            PG8_LDB(B0, 1, 0); PG8_SCHED; PG8_LDA(At, 1, 0); PG8_STAGE(PG8_SA(0, 1), a2 + hstep, voffA);
            PG8_WAIT_L(8); PG8_BAR; PG8_WAIT_L(0); PG8_MMA(0, 0, At, B0); PG8_BAR; PG8_SCHED;
            PG8_LDB(B1, 1, 1); PG8_STAGE(PG8_SB(1, 0), b3, voffB);
            PG8_BAR; PG8_WAIT_L(0); PG8_MMA(0, 1, At, B1); PG8_BAR;
            PG8_LDA(At, 1, 1); PG8_STAGE(PG8_SA(1, 0), a3, voffA);
            PG8_BAR; PG8_WAIT_L(0); PG8_MMA(1, 0, At, B0); PG8_BAR; PG8_SCHED;
            PG8_STAGE(PG8_SB(1, 1), b3 + hstep, voffB);
            PG8_WAIT_V(6); PG8_BAR; PG8_MMA(1, 1, At, B1); PG8_BAR;
            }
        }
        if constexpr (ALIGN_EPI) { if (wr == 0) PG8_BAR; }
        if constexpr (!Epi::AFTER_DRAIN) { E(acc, cur, wr, wc, fr, fq); S.done(cur); }
        if (!has_next) break;
#pragma unroll
        for (int a = 0; a < 2; ++a)
#pragma unroll
            for (int b = 0; b < 2; ++b)
#pragma unroll
                for (int m = 0; m < 4; ++m)
#pragma unroll
                    for (int n = 0; n < 2; ++n) acc[a][b][m][n] = (f32x4){0.f, 0.f, 0.f, 0.f};
        cur = nxt; cA = nA; cB = nB; ++ui;
        if constexpr (ALIGN_EPI) { if (wr == 1) PG8_BAR; }
    }
    PG8_WAIT_V(0);
    if constexpr (!ALIGN_EPI) { if (wr == 0) PG8_BAR; }
    PG8_BAR;
    if constexpr (Epi::AFTER_DRAIN) { E.fused(acc, cur, wr, wc, fr, fq, lds, wid, lane); S.done(cur); }
#undef PG8_SA
#undef PG8_SB
#undef PG8_STAGE
#undef PG8_LDA
#undef PG8_LDB
#undef PG8_MMA
#undef PG8_WAIT_V
#undef PG8_WAIT_L
#undef PG8_BAR
#undef PG8_SCHED
}
}
#define LAS __attribute__((address_space(3)))
typedef unsigned short bf16;
typedef float f32x4 __attribute__((ext_vector_type(4)));
typedef unsigned v4u __attribute__((ext_vector_type(4)));
typedef unsigned v2u __attribute__((ext_vector_type(2)));
constexpr int M = 16384, D = 1024, FF = 2816, SEQ = 4096, NB = 4;
constexpr float LN_EPS = 1e-5f;
constexpr float ALPHA = 1.6817928305074290f;
constexpr size_t MiB = 1u << 20;
constexpr size_t WS_CTL = 0;
constexpr size_t WS_WGU = 1 * MiB;
constexpr size_t SZ_WGU = (size_t)5632 * 1024 * 2;
constexpr size_t WS_WD = WS_WGU + 8 * SZ_WGU;
constexpr size_t SZ_WD = (size_t)1024 * 2816 * 2;
constexpr size_t WS_AIN = WS_WD + 8 * SZ_WD;
constexpr size_t SZ_AIN = (size_t)3072 * 1024 * 2;
constexpr size_t SZ_SQ = (size_t)1024 * 1024 * 2;
constexpr size_t WS_AOUT = WS_AIN + 2 * SZ_AIN;
constexpr size_t WS_BIN = WS_AOUT + 2 * SZ_SQ;
constexpr size_t WS_BCOMB = WS_BIN + SZ_SQ;
constexpr size_t WS_CIN = WS_BCOMB + SZ_SQ;
constexpr size_t WS_COUT = WS_CIN + 4 * SZ_SQ;
constexpr size_t WS_XB = WS_COUT + SZ_SQ;
constexpr size_t WS_Y = WS_XB + (size_t)M * D * 2;
constexpr size_t WS_HB = WS_Y + (size_t)M * D * 4;
constexpr size_t WS_MX = WS_HB + (size_t)M * FF * 2;
constexpr size_t WS_END = WS_MX + 290 * MiB;
constexpr size_t MX_QK = 0, MX_VT = 64 * MiB, MX_O = 96 * MiB, MX_KMEAN = 128 * MiB, MX_KN = 129 * MiB;
constexpr size_t MX_U = 0, MX_P = 32 * MiB;
constexpr size_t MX_PROJ = 0, MX_QC = 128 * MiB, MX_KC = 160 * MiB, MX_HT = 192 * MiB  , MX_GATES = 256 * MiB, MX_HN2 = 257 * MiB  ;

constexpr int LDS_BYTES = 147456;

__device__ const unsigned char T5_BUCKET[128] = {0, 1, 2, 3, 4, 5, 6, 7, 8, 9, 10, 11, 12, 13, 14, 15, 16, 16, 16, 17, 17, 18, 18, 18, 19, 19, 19, 20, 20, 20, 20, 21, 21, 21, 21, 22, 22, 22, 22, 22, 23, 23, 23, 23, 23, 23, 24, 24, 24, 24, 24, 24, 25, 25, 25, 25, 25, 25, 25, 26, 26, 26, 26, 26, 26, 26, 26, 27, 27, 27, 27, 27, 27, 27, 27, 27, 27, 28, 28, 28, 28, 28, 28, 28, 28, 28, 28, 29, 29, 29, 29, 29, 29, 29, 29, 29, 29, 29, 29, 30, 30, 30, 30, 30, 30, 30, 30, 30, 30, 30, 30, 30, 30, 31, 31, 31, 31, 31, 31, 31, 31, 31, 31, 31, 31, 31, 31, 31};

__device__ __forceinline__ unsigned f2bf(float f) { unsigned u = __builtin_bit_cast(unsigned, f); return (u + 0x7fffu + ((u >> 16) & 1u)) >> 16; }
__device__ __forceinline__ unsigned pk2(float lo, float hi) { return f2bf(lo) | (f2bf(hi) << 16); }
__device__ __forceinline__ float bf_lo(unsigned w) { return __builtin_bit_cast(float, w << 16); }
__device__ __forceinline__ float bf_hi(unsigned w) { return __builtin_bit_cast(float, w & 0xffff0000u); }
__device__ __forceinline__ float bf1(bf16 v) { return __builtin_bit_cast(float, (unsigned)v << 16); }
__device__ __forceinline__ float shx(float v, int o, int lane) { return __builtin_bit_cast(float, __builtin_amdgcn_ds_bpermute((lane ^ o) << 2, __builtin_bit_cast(int, v))); }
__device__ __forceinline__ float shidx(float v, int src) { return __builtin_bit_cast(float, __builtin_amdgcn_ds_bpermute(src << 2, __builtin_bit_cast(int, v))); }
__device__ __forceinline__ float wave_sum(float v, int lane) {
#pragma unroll
    for (int o = 1; o < 64; o <<= 1) v += shx(v, o, lane);
    return v;
}
__device__ __forceinline__ float wave_max(float v, int lane) {
#pragma unroll
    for (int o = 1; o < 64; o <<= 1) v = fmaxf(v, shx(v, o, lane));
    return v;
}
#define LDS_WAIT() asm volatile("s_waitcnt lgkmcnt(0)" ::: "memory")

struct Args {
    const float* x; const float* rel_bias; const float* ln_g; const float* ln_b; const float* ffn_w_gu; const float* ffn_w_down;
    const float* a_w_in; const float* a_w_out; const float* b_w_in; const float* b_w_group; const float* b_scale; const float* b_w_out;
    const float* c_w_in; const float* c_b_gates; const float* c_conv_w; const float* c_norm_g; const float* c_w_out;
    float* out; unsigned char* ws;
};

__device__ __forceinline__ void transpose_item(const float* W, int ldw, int K, bf16* WT, int k0, int n0, int drow0, LAS float* scr, int lane) {
#pragma unroll 8
    for (int i = 0; i < 32; ++i) { const int kk = 2 * i + (lane >> 5); scr[kk * 33 + (lane & 31)] = W[(size_t)(k0 + kk) * ldw + n0 + (lane & 31)]; }
    LDS_WAIT(); asm volatile("" ::: "memory");
    const int c = lane & 7;
#pragma unroll
    for (int j = 0; j < 4; ++j) { const int n = (lane >> 3) + 8 * j; const LAS float* s = scr + (8 * c) * 33 + n;
        v4u o; o.x = pk2(s[0 * 33], s[1 * 33]); o.y = pk2(s[2 * 33], s[3 * 33]); o.z = pk2(s[4 * 33], s[5 * 33]); o.w = pk2(s[6 * 33], s[7 * 33]);
        *(v4u*)(WT + (size_t)(drow0 + n) * K + k0 + 8 * c) = o; }
    LDS_WAIT(); asm volatile("" ::: "memory");
}
__device__ __forceinline__ void tr_plain(const float* W, int ldw, int K, int ncols, bf16* WT, int r, LAS float* scr, int lane) {
    const int nblk = ncols / 32, kb = r / nblk, nb = r % nblk;
    transpose_item(W, ldw, K, WT, 64 * kb, 32 * nb, 32 * nb, scr, lane);
}

__device__ __forceinline__ void p0_prologue(const Args& a, LAS unsigned char* lds, int gw, int NGW, int wave, int lane) {
    LAS float* scr = (LAS float*)(lds + wave * 16384);
    unsigned char* ws = a.ws;
    constexpr int I_GU = 16 * 176, I_DN = 44 * 32, I_AIN = 16 * 96, I_SQ = 16 * 32, I_CIN = 16 * 128;
    constexpr int NITEMS = 8 * I_GU + 8 * I_DN + 2 * I_AIN + 2 * I_SQ + I_SQ + I_CIN + I_SQ;
    for (int it = gw; it < NITEMS; it += NGW) {
        int r = it;
        if (r < 8 * I_GU) { const int mi = r / I_GU; r -= mi * I_GU; const int kb = r / 176, nb = r % 176, n0 = 32 * nb;
            const int drow0 = (n0 < FF) ? ((n0 >> 7) * 256 + (n0 & 127)) : ((((n0 - FF) >> 7) * 256) + 128 + ((n0 - FF) & 127));
            transpose_item(a.ffn_w_gu + (size_t)mi * 1024 * 5632, 5632, 1024, (bf16*)(ws + WS_WGU + mi * SZ_WGU), 64 * kb, n0, drow0, scr, lane); continue; }
        r -= 8 * I_GU;
        if (r < 8 * I_DN) { const int mi = r / I_DN; r -= mi * I_DN; tr_plain(a.ffn_w_down + (size_t)mi * 2816 * 1024, 1024, 2816, 1024, (bf16*)(ws + WS_WD + mi * SZ_WD), r, scr, lane); continue; }
        r -= 8 * I_DN;
        if (r < 2 * I_AIN) { const int mi = r / I_AIN; r -= mi * I_AIN; tr_plain(a.a_w_in + (size_t)mi * 1024 * 3072, 3072, 1024, 3072, (bf16*)(ws + WS_AIN + mi * SZ_AIN), r, scr, lane); continue; }
        r -= 2 * I_AIN;
        if (r < 2 * I_SQ) { const int mi = r / I_SQ; r -= mi * I_SQ; tr_plain(a.a_w_out + (size_t)mi * 1024 * 1024, 1024, 1024, 1024, (bf16*)(ws + WS_AOUT + mi * SZ_SQ), r, scr, lane); continue; }
        r -= 2 * I_SQ;
        if (r < I_SQ) { tr_plain(a.b_w_in, 1024, 1024, 1024, (bf16*)(ws + WS_BIN), r, scr, lane); continue; }
        r -= I_SQ;
        if (r < I_CIN) { tr_plain(a.c_w_in, 4104, 1024, 4096, (bf16*)(ws + WS_CIN), r, scr, lane); continue; }
        r -= I_CIN;
        tr_plain(a.c_w_out, 1024, 1024, 1024, (bf16*)(ws + WS_COUT), r, scr, lane);
    }
    {
        bf16* WT = (bf16*)(ws + WS_BCOMB);
        const int gt = gw * 64 + lane, NT = NGW * 64;
        for (int o = gt; o < 1024 * 1024; o += NT) {
            const int k = o >> 10, n = o & 1023, g = k >> 8;
            const float* wg = a.b_w_group + (size_t)k * 256; const float* sc = a.b_scale + g * 256; const float* wo = a.b_w_out + (size_t)(g * 256) * 1024 + n;
            float acc = 0.f;
#pragma unroll 8
            for (int d = 0; d < 256; ++d) acc += wg[d] * sc[d] * wo[(size_t)d * 1024];
            WT[(size_t)n * 1024 + k] = (bf16)f2bf(acc);
        }
    }
    {
        bf16* XB = (bf16*)(ws + WS_XB);
        const int gt = gw * 64 + lane, NT = NGW * 64;
        for (int o = gt; o < M * D / 8; o += NT) {
            const f32x4 v0 = ((const f32x4*)a.x)[2 * o], v1 = ((const f32x4*)a.x)[2 * o + 1];
            v4u w; w.x = pk2(v0.x, v0.y); w.y = pk2(v0.z, v0.w); w.z = pk2(v1.x, v1.y); w.w = pk2(v1.z, v1.w);
            ((v4u*)XB)[o] = w;
        }
    }
}

__device__ __forceinline__ void ln_phase(const float* Y, const float* g, const float* b, float* X, bf16* XB, int gw, int NGW, int lane) {
    f32x4 gv[4], bv[4];
#pragma unroll
    for (int j = 0; j < 4; ++j) { gv[j] = ((const f32x4*)g)[lane + 64 * j]; bv[j] = ((const f32x4*)b)[lane + 64 * j]; }
    for (int m = gw; m < M; m += NGW) {
        const f32x4* yr = (const f32x4*)(Y + (size_t)m * D) + lane;
        f32x4 v[4]; float s = 0.f;
#pragma unroll
        for (int j = 0; j < 4; ++j) { v[j] = yr[64 * j]; s += (v[j].x + v[j].y) + (v[j].z + v[j].w); }
        const float mean = wave_sum(s, lane) * (1.f / D); float s2 = 0.f;
#pragma unroll
        for (int j = 0; j < 4; ++j) { v[j] = v[j] - mean; s2 += (v[j].x * v[j].x + v[j].y * v[j].y) + (v[j].z * v[j].z + v[j].w * v[j].w); }
        const float rstd = 1.f / sqrtf(wave_sum(s2, lane) * (1.f / D) + LN_EPS);
        f32x4* xo = (f32x4*)(X + (size_t)m * D) + lane; v2u* bo = (v2u*)(XB + (size_t)m * D) + lane;
#pragma unroll
        for (int j = 0; j < 4; ++j) { const f32x4 o = v[j] * rstd * gv[j] + bv[j]; xo[64 * j] = o; v2u w; w.x = pk2(o.x, o.y); w.y = pk2(o.z, o.w); bo[64 * j] = w; }
    }
}
__device__ __forceinline__ void kmean_phase(const bf16* QK, float* KMEAN, unsigned* KN, LAS unsigned char* lds, int tid, int G) {
    LAS float* red = (LAS float*)lds;
    const int wave = tid >> 6, lane = tid & 63;
    for (int u = blockIdx.x; u < 512; u += G) {
        const int h = u & 7, j = (u >> 3) & 15, b = u >> 7;
        const bf16* kb = QK + (size_t)(b * 4096 + j * 256) * 2048 + 1024 + h * 128;
        const int d = tid & 127, rq = tid >> 7;
        float s = 0.f;
        for (int r = rq * 64; r < rq * 64 + 64; ++r) s += bf1(kb[(size_t)r * 2048 + d]);
        red[rq * 128 + d] = s;
        float mx = 0.f;
        for (int r = wave * 32; r < wave * 32 + 32; ++r) { const unsigned w = *(const unsigned*)(kb + (size_t)r * 2048 + 2 * lane); const float a = bf_lo(w), c = bf_hi(w); mx = fmaxf(mx, wave_sum(a * a + c * c, lane)); }
        if (lane == 0) red[512 + wave] = mx;
        __syncthreads();
        if (tid < 128) KMEAN[((size_t)(b * 8 + h) * 16 + j) * 128 + tid] = (red[tid] + red[128 + tid] + red[256 + tid] + red[384 + tid]) * (1.f / 256.f);
        if (tid == 0) { float m8 = red[512]; for (int w = 1; w < 8; ++w) m8 = fmaxf(m8, red[512 + w]); KN[(b * 8 + h) * 16 + j] = __float_as_uint(m8); }
        __syncthreads();
    }
}
#define DOT8(W_, QA_, QB_) (bf_lo((W_).x) * (QA_).x + bf_hi((W_).x) * (QA_).y + bf_lo((W_).y) * (QA_).z + bf_hi((W_).y) * (QA_).w + bf_lo((W_).z) * (QB_).x + bf_hi((W_).z) * (QB_).y + bf_lo((W_).w) * (QB_).z + bf_hi((W_).w) * (QB_).w)
__device__ __forceinline__ void attn_valu_phase(const bf16* QK, const bf16* VT, const float* KMEAN, const float* rel_bias, bf16* O, LAS unsigned char* lds, int gw, int NGW, int wave, int lane) {
    LAS float* qs = (LAS float*)(lds + wave * 8192);
    LAS float* ps = qs + 128;
    const float scale = 0.08838834764831845f, NINF = -__builtin_inff();
    for (int idx = gw; idx < NB * 8 * SEQ; idx += NGW) {
        const int s = idx & 4095, bh = idx >> 12, h = bh & 7, b = bh >> 3, qb = s >> 8; const size_t row = (size_t)b * 4096 + s;
        const unsigned qq = *(const unsigned*)(QK + row * 2048 + h * 128 + 2 * lane);
        const float q0 = bf_lo(qq), q1 = bf_hi(qq);
        qs[2 * lane] = q0; qs[2 * lane + 1] = q1;
        float t0 = NINF, t1 = NINF, t2 = NINF; int i0 = 0, i1 = 1, i2 = 2;
        const float* km = KMEAN + (size_t)(b * 8 + h) * 16 * 128;
        for (int j = 0; j < qb; ++j) { const float g = wave_sum(q0 * km[j * 128 + 2 * lane] + q1 * km[j * 128 + 2 * lane + 1], lane);
            if (g > t0) { t2 = t1; i2 = i1; t1 = t0; i1 = i0; t0 = g; i0 = j; } else if (g > t1) { t2 = t1; i2 = i1; t1 = g; i1 = j; } else if (g > t2) { t2 = g; i2 = j; } }
        const int nsel = qb < 3 ? qb : 3;
        LDS_WAIT(); asm volatile("" ::: "memory");
        float mx = NINF;
        for (int blk = 0; blk <= nsel; ++blk) {
            const int kb = blk == 0 ? qb : (blk == 1 ? i0 : (blk == 2 ? i1 : i2));
            for (int kk = 0; kk < 4; ++kk) {
                const int key = kb * 256 + kk * 64 + lane;
                const bf16* kr = QK + ((size_t)b * 4096 + key) * 2048 + 1024 + h * 128;
                float dot = 0.f;
#pragma unroll 4
                for (int c = 0; c < 16; ++c) { const v4u w = *(const v4u*)(kr + 8 * c); const f32x4 qa = *(const LAS f32x4*)(qs + 8 * c), qc = *(const LAS f32x4*)(qs + 8 * c + 4); dot += DOT8(w, qa, qc); }
                const int dist = s - key;
                float sc = NINF;
                if (dist >= 0) { const int bucket = dist < 128 ? (int)T5_BUCKET[dist] : 31; sc = dot * scale + rel_bias[bucket * 8 + h]; }
                ps[blk * 256 + kk * 64 + lane] = sc; mx = fmaxf(mx, sc);
            }
        }
        mx = wave_max(mx, lane);
        LDS_WAIT(); asm volatile("" ::: "memory");
        float l = 0.f;
        const int nk = (nsel + 1) * 256;
        for (int i = lane; i < nk; i += 64) { const float p = __expf(ps[i] - mx); ps[i] = p; l += p; }
        l = wave_sum(l, lane);
        LDS_WAIT(); asm volatile("" ::: "memory");
        float o0 = 0.f, o1 = 0.f;
        for (int blk = 0; blk <= nsel; ++blk) {
            const int kb = blk == 0 ? qb : (blk == 1 ? i0 : (blk == 2 ? i1 : i2));
            const bf16* v0p = VT + (size_t)(h * 128 + 2 * lane) * M + (size_t)b * 4096 + kb * 256; const bf16* v1p = v0p + M;
#pragma unroll 4
            for (int k8 = 0; k8 < 32; ++k8) { const v4u a = *(const v4u*)(v0p + 8 * k8), c = *(const v4u*)(v1p + 8 * k8);
                const f32x4 pa = *(const LAS f32x4*)(ps + blk * 256 + 8 * k8), pb = *(const LAS f32x4*)(ps + blk * 256 + 8 * k8 + 4);
                o0 += DOT8(a, pa, pb); o1 += DOT8(c, pa, pb); }
        }
        const float inv = 1.f / l;
        *(unsigned*)(O + row * 1024 + h * 128 + 2 * lane) = pk2(o0 * inv, o1 * inv);
        LDS_WAIT(); asm volatile("" ::: "memory");
    }
}
__device__ __forceinline__ void pool_phase(const bf16* U, bf16* P, int gt, int NT) {
    for (int o = gt; o < M * 128; o += NT) {
        const int row = o >> 7, c8 = (o & 127) * 8, s = row & 4095, g = c8 >> 8, w = 2 << g;
        const int cnt = (s + 1 < w) ? s + 1 : w;
        float a0 = 0, a1 = 0, a2 = 0, a3 = 0, a4 = 0, a5 = 0, a6 = 0, a7 = 0;
        const v4u cur = *(const v4u*)(U + (size_t)row * 1024 + c8);
        for (int i = 0; i < cnt; ++i) { const v4u v = *(const v4u*)(U + (size_t)(row - i) * 1024 + c8);
            a0 += bf_lo(v.x); a1 += bf_hi(v.x); a2 += bf_lo(v.y); a3 += bf_hi(v.y); a4 += bf_lo(v.z); a5 += bf_hi(v.z); a6 += bf_lo(v.w); a7 += bf_hi(v.w); }
        const float ic = 1.f / (float)cnt;
        v4u r; r.x = pk2(a0 * ic - bf_lo(cur.x), a1 * ic - bf_hi(cur.x)); r.y = pk2(a2 * ic - bf_lo(cur.y), a3 * ic - bf_hi(cur.y));
        r.z = pk2(a4 * ic - bf_lo(cur.z), a5 * ic - bf_hi(cur.z)); r.w = pk2(a6 * ic - bf_lo(cur.w), a7 * ic - bf_hi(cur.w));
        *(v4u*)(P + (size_t)row * 1024 + c8) = r;
    }
}
__device__ __forceinline__ void gates_phase(const float* X, const float* c_w_in, const float* c_b_gates, float* GATES, int gw, int NGW, int lane) {
    for (int m = gw; m < M; m += NGW) {
        f32x4 a0 = {0.f, 0.f, 0.f, 0.f}, a1 = {0.f, 0.f, 0.f, 0.f};
#pragma unroll
        for (int j = 0; j < 4; ++j) { const f32x4 xv = ((const f32x4*)(X + (size_t)m * D))[lane + 64 * j]; const int k = (lane + 64 * j) * 4;
#pragma unroll
            for (int e = 0; e < 4; ++e) { const float* wr = c_w_in + (size_t)(k + e) * 4104 + 4096; const f32x4 w0 = *(const f32x4*)wr, w1 = *(const f32x4*)(wr + 4); a0 += w0 * xv[e]; a1 += w1 * xv[e]; } }
        float r0 = wave_sum(a0.x, lane), r1 = wave_sum(a0.y, lane), r2 = wave_sum(a0.z, lane), r3 = wave_sum(a0.w, lane), r4 = wave_sum(a1.x, lane), r5 = wave_sum(a1.y, lane), r6 = wave_sum(a1.z, lane), r7 = wave_sum(a1.w, lane);
        if (lane < 8) { const float v = lane == 0 ? r0 : lane == 1 ? r1 : lane == 2 ? r2 : lane == 3 ? r3 : lane == 4 ? r4 : lane == 5 ? r5 : lane == 6 ? r6 : r7; GATES[(size_t)m * 8 + lane] = v + c_b_gates[lane]; }
    }
}
__device__ __forceinline__ void conv_phase(const bf16* PROJ, const float* conv_w, bf16* QC, bf16* KC, int gt, int NT) {
    for (int o = gt; o < M * 256; o += NT) {
        const int row = o >> 8, c8 = (o & 255) * 8, s = row & 4095;
        f32x4 lo = {0.f, 0.f, 0.f, 0.f}, hi = {0.f, 0.f, 0.f, 0.f};
#pragma unroll
        for (int j = 0; j < 4; ++j) { if (s - 3 + j >= 0) { const v4u v = *(const v4u*)(PROJ + (size_t)(row - 3 + j) * 4096 + c8);
                const f32x4 w0 = *(const f32x4*)(conv_w + j * 2048 + c8), w1 = *(const f32x4*)(conv_w + j * 2048 + c8 + 4);
                lo += w0 * (f32x4){bf_lo(v.x), bf_hi(v.x), bf_lo(v.y), bf_hi(v.y)}; hi += w1 * (f32x4){bf_lo(v.z), bf_hi(v.z), bf_lo(v.w), bf_hi(v.w)}; } }
        const float sc = c8 >= 1024 ? 0.0625f : 1.0f;
        v4u r; r.x = pk2(pg8::silu_f(lo.x) * sc, pg8::silu_f(lo.y) * sc); r.y = pk2(pg8::silu_f(lo.z) * sc, pg8::silu_f(lo.w) * sc);
        r.z = pk2(pg8::silu_f(hi.x) * sc, pg8::silu_f(hi.y) * sc); r.w = pk2(pg8::silu_f(hi.z) * sc, pg8::silu_f(hi.w) * sc);
        if (c8 >= 1024) *(v4u*)(KC + (size_t)row * 1024 + (c8 - 1024)) = r; else *(v4u*)(QC + (size_t)row * 1024 + c8) = r;
    }
}
__device__ __forceinline__ void mlstm_valu_phase(const bf16* QC, const bf16* KC, const bf16* PROJ, const float* GATES, float* HT, LAS unsigned char* lds, int tid, int G) {
    LAS float* Cst = (LAS float*)lds;
    LAS float* nst = Cst + 256 * 33;
    LAS bf16* qs = (LAS bf16*)(nst + 256);
    LAS bf16* ks = qs + 64 * 264;
    LAS float* vsm = (LAS float*)(ks + 64 * 264);
    LAS float* Wm = vsm + 64 * 33;
    LAS float* sv = Wm + 64 * 65;
    for (int u = blockIdx.x; u < 128; u += G) {
        const int vsl = u & 7, h = (u >> 3) & 3, b = u >> 5;
        for (int i = tid; i < 256 * 33; i += 512) Cst[i] = 0.f;
        if (tid < 256) nst[tid] = 0.f;
        if (tid == 0) sv[320] = 0.f;
        __syncthreads();
        for (int c = 0; c < 64; ++c) {
            const size_t row0 = (size_t)b * 4096 + c * 64;
            for (int i = tid; i < 2048; i += 512) { const int r = i >> 5, c8 = (i & 31) * 8;
                *(LAS v4u*)(qs + r * 264 + c8) = *(const v4u*)(QC + (row0 + r) * 1024 + h * 256 + c8);
                *(LAS v4u*)(ks + r * 264 + c8) = *(const v4u*)(KC + (row0 + r) * 1024 + h * 256 + c8); }
            { const int r = tid >> 3, c4 = (tid & 7) * 4; const v2u w = *(const v2u*)(PROJ + (row0 + r) * 4096 + 2048 + h * 256 + vsl * 32 + c4);
              vsm[r * 33 + c4] = bf_lo(w.x); vsm[r * 33 + c4 + 1] = bf_hi(w.x); vsm[r * 33 + c4 + 2] = bf_lo(w.y); vsm[r * 33 + c4 + 3] = bf_hi(w.y); }
            if (tid < 64) {
                const float ig = GATES[(row0 + tid) * 8 + h], fp = GATES[(row0 + tid) * 8 + 4 + h];
                const float lf = fminf(fp, 0.f) - log1pf(__expf(-fabsf(fp)));
                float bsum = lf;
#pragma unroll
                for (int o = 1; o < 64; o <<= 1) { const float t = shidx(bsum, tid - o); if (tid >= o) bsum += t; }
                const float av = ig - bsum;
                float cm = av;
#pragma unroll
                for (int o = 1; o < 64; o <<= 1) { const float t = shidx(cm, tid - o); if (tid >= o) cm = fmaxf(cm, t); }
                const float mp = sv[320];
                const float m_inter = bsum + mp, mt = fmaxf(m_inter, bsum + cm);
                const float blast = shidx(bsum, 63);
                const float gs = blast - bsum + ig;
                const float mnew = fmaxf(blast + mp, wave_max(gs, tid));
                sv[tid] = bsum; sv[64 + tid] = av; sv[128 + tid] = mt; sv[192 + tid] = __expf(m_inter - mt); sv[256 + tid] = __expf(gs - mnew);
                if (tid == 0) { sv[321] = __expf(blast + mp - mnew); sv[322] = mnew; }
            }
            __syncthreads();
            { const int t = tid >> 3, sg = tid & 7; const float bt = sv[t], mt = sv[128 + t];
              float d0 = 0, d1 = 0, d2 = 0, d3 = 0, d4 = 0, d5 = 0, d6 = 0, d7 = 0;
              if (sg * 8 <= t) {
                  for (int dk8 = 0; dk8 < 32; ++dk8) { const v4u qv = *(const LAS v4u*)(qs + t * 264 + dk8 * 8);
                      const f32x4 qa = {bf_lo(qv.x), bf_hi(qv.x), bf_lo(qv.y), bf_hi(qv.y)}, qc = {bf_lo(qv.z), bf_hi(qv.z), bf_lo(qv.w), bf_hi(qv.w)};
                      const LAS bf16* kp = ks + (sg * 8) * 264 + dk8 * 8;
                      { const v4u w = *(const LAS v4u*)(kp + 0 * 264); d0 += DOT8(w, qa, qc); } { const v4u w = *(const LAS v4u*)(kp + 1 * 264); d1 += DOT8(w, qa, qc); }
                      { const v4u w = *(const LAS v4u*)(kp + 2 * 264); d2 += DOT8(w, qa, qc); } { const v4u w = *(const LAS v4u*)(kp + 3 * 264); d3 += DOT8(w, qa, qc); }
                      { const v4u w = *(const LAS v4u*)(kp + 4 * 264); d4 += DOT8(w, qa, qc); } { const v4u w = *(const LAS v4u*)(kp + 5 * 264); d5 += DOT8(w, qa, qc); }
                      { const v4u w = *(const LAS v4u*)(kp + 6 * 264); d6 += DOT8(w, qa, qc); } { const v4u w = *(const LAS v4u*)(kp + 7 * 264); d7 += DOT8(w, qa, qc); } }
              }
#define WSTORE(e, dv) { const int s_ = sg * 8 + e; Wm[t * 65 + s_] = (s_ <= t) ? __expf(bt + sv[64 + s_] - mt) * dv : 0.f; }
              WSTORE(0, d0) WSTORE(1, d1) WSTORE(2, d2) WSTORE(3, d3) WSTORE(4, d4) WSTORE(5, d5) WSTORE(6, d6) WSTORE(7, d7)
#undef WSTORE
            }
            __syncthreads();
            { const int t = tid >> 3, vg = tid & 7; const float sint = sv[192 + t], mt = sv[128 + t];
              f32x4 inter = {0.f, 0.f, 0.f, 0.f}, intra = {0.f, 0.f, 0.f, 0.f}; float qn = 0.f, wsum = 0.f;
              for (int dk = 0; dk < 256; ++dk) { const float qv = bf1(qs[t * 264 + dk]); qn += qv * nst[dk]; const LAS float* cp = Cst + dk * 33 + vg * 4; inter += (f32x4){cp[0], cp[1], cp[2], cp[3]} * qv; }
              for (int s = 0; s <= t; ++s) { const float w = Wm[t * 65 + s]; wsum += w; const LAS float* vp = vsm + s * 33 + vg * 4; intra += (f32x4){vp[0], vp[1], vp[2], vp[3]} * w; }
              const float den = sint * qn + wsum; const float dd = 1.f / fmaxf(fabsf(den), __expf(-mt));
              *(f32x4*)(HT + (row0 + t) * 1024 + h * 256 + vsl * 32 + vg * 4) = (inter * sint + intra) * dd; }
            __syncthreads();
            { const int dk = tid >> 1, hf = tid & 1; const float decay = sv[321];
              f32x4 c0 = {0.f, 0.f, 0.f, 0.f}, c1 = c0, c2 = c0, c3 = c0; float nacc = 0.f;
              for (int s = 0; s < 64; ++s) { const float kw = bf1(ks[s * 264 + dk]) * sv[256 + s]; nacc += kw; const LAS float* vp = vsm + s * 33 + hf * 16;
                  c0 += (f32x4){vp[0], vp[1], vp[2], vp[3]} * kw; c1 += (f32x4){vp[4], vp[5], vp[6], vp[7]} * kw; c2 += (f32x4){vp[8], vp[9], vp[10], vp[11]} * kw; c3 += (f32x4){vp[12], vp[13], vp[14], vp[15]} * kw; }
              LAS float* cp = Cst + dk * 33 + hf * 16;
#pragma unroll
              for (int e = 0; e < 4; ++e) { cp[e] = decay * cp[e] + c0[e]; cp[4 + e] = decay * cp[4 + e] + c1[e]; cp[8 + e] = decay * cp[8 + e] + c2[e]; cp[12 + e] = decay * cp[12 + e] + c3[e]; }
              if (hf == 0) nst[dk] = decay * nst[dk] + nacc;
              if (tid == 0) sv[320] = sv[322]; }
            __syncthreads();
        }
    }
}
__device__ __forceinline__ void headnorm_phase(const float* HT, const bf16* PROJ, const float* norm_g, bf16* HN, int gw, int NGW, int lane) {
    for (int m = gw; m < M; m += NGW) {
#pragma unroll
        for (int hh = 0; hh < 4; ++hh) { const int idx = hh * 256 + lane * 4;
            const f32x4 ht = *(const f32x4*)(HT + (size_t)m * 1024 + idx); const v2u ow = *(const v2u*)(PROJ + (size_t)m * 4096 + 3072 + idx);
            const f32x4 op = {bf_lo(ow.x), bf_hi(ow.x), bf_lo(ow.y), bf_hi(ow.y)};
            f32x4 hc;
#pragma unroll
            for (int e = 0; e < 4; ++e) hc[e] = ht[e] / (1.f + __expf(-op[e]));
            const float mu = wave_sum((hc.x + hc.y) + (hc.z + hc.w), lane) * (1.f / 256.f);
            hc = hc - mu;
            const float var = wave_sum((hc.x * hc.x + hc.y * hc.y) + (hc.z * hc.z + hc.w * hc.w), lane) * (1.f / 256.f);
            const float rstd = 1.f / sqrtf(var + LN_EPS);
            const f32x4 ng = *(const f32x4*)(norm_g + idx);
            const f32x4 o = hc * rstd * ng;
            v2u w; w.x = pk2(o.x, o.y); w.y = pk2(o.z, o.w);
            *(v2u*)(HN + (size_t)m * 1024 + idx) = w; }
    }
}
typedef short bf16x8v __attribute__((ext_vector_type(8)));
typedef float f32x16 __attribute__((ext_vector_type(16)));
typedef float f32x2_t __attribute__((ext_vector_type(2)));
typedef __bf16 bf16x2_t __attribute__((ext_vector_type(2)));
__device__ __forceinline__ unsigned cvtpk(float lo, float hi) { f32x2_t v = {lo, hi}; bf16x2_t b = __builtin_convertvector(v, bf16x2_t); return __builtin_bit_cast(unsigned, b); }
constexpr int AT_KROW = 272, AT_VROW = 528, AT_KS = 0, AT_VS = 256 * AT_KROW, AT_KML = AT_VS + 128 * AT_VROW, AT_BL = AT_KML + 8192;
static_assert(AT_BL + 512 <= LDS_BYTES, "attention LDS map");
template <int MODE  >
__device__ __forceinline__ void attn_block(LAS unsigned char* lds, const bf16x8v (&qf)[8], f32x16 (&oacc)[4], float& lsum, int ql, int hi, int qi, float c1, float cfar, float negm, float rs) {
    const LAS unsigned char* Ks = lds + AT_KS; const LAS unsigned char* Vs = lds + AT_VS; const LAS float* bl = (const LAS float*)(lds + AT_BL);
#pragma unroll 1
    for (int kt = 0; kt < 8; ++kt) {
        f32x16 sacc;
#pragma unroll
        for (int i = 0; i < 16; ++i) sacc[i] = 0.f;
#pragma unroll
        for (int dd = 0; dd < 8; ++dd) { const bf16x8v kf = *(const LAS bf16x8v*)(Ks + (kt * 32 + ql) * AT_KROW + dd * 32 + hi * 16); sacc = __builtin_amdgcn_mfma_f32_32x32x16_bf16(kf, qf[dd], sacc, 0, 0, 0); }
        float p[16];
#pragma unroll
        for (int i = 0; i < 16; ++i) {
            const int key = kt * 32 + (i & 3) + 8 * (i >> 2) + 4 * hi;
            float x;
            if (MODE == 0) x = sacc[i] * c1 + cfar;
            else { int dist = (MODE == 1 ? 256 : 0) + qi - key; int idx = dist < 0 ? 0 : (dist > 127 ? 127 : dist); x = sacc[i] * c1 + (bl[idx] + negm); }
            float e = __builtin_amdgcn_exp2f(x) * rs;
            if (MODE == 2) e = (key <= qi) ? e : 0.f;
            p[i] = e; lsum += e;
        }
        v4u pw0, pw1;
        pw0.x = cvtpk(p[0], p[1]); pw0.y = cvtpk(p[2], p[3]); pw0.z = cvtpk(p[4], p[5]); pw0.w = cvtpk(p[6], p[7]);
        pw1.x = cvtpk(p[8], p[9]); pw1.y = cvtpk(p[10], p[11]); pw1.z = cvtpk(p[12], p[13]); pw1.w = cvtpk(p[14], p[15]);
        const bf16x8v pf0 = __builtin_bit_cast(bf16x8v, pw0), pf1 = __builtin_bit_cast(bf16x8v, pw1);
#pragma unroll
        for (int dt = 0; dt < 4; ++dt) {
            const bf16x8v v0 = *(const LAS bf16x8v*)(Vs + (dt * 32 + ql) * AT_VROW + kt * 64 + hi * 16);
            const bf16x8v v1 = *(const LAS bf16x8v*)(Vs + (dt * 32 + ql) * AT_VROW + kt * 64 + 32 + hi * 16);
            oacc[dt] = __builtin_amdgcn_mfma_f32_32x32x16_bf16(v0, pf0, oacc[dt], 0, 0, 0);
            oacc[dt] = __builtin_amdgcn_mfma_f32_32x32x16_bf16(v1, pf1, oacc[dt], 0, 0, 0);
        }
    }
}
__device__ __forceinline__ void attn_mfma_phase(const bf16* QK, const bf16* VT, const float* KMEAN, const unsigned* KN, const float* rel_bias, bf16* O, LAS unsigned char* lds, int tid, int G) {
    constexpr float LOG2E = 1.4426950408889634f, SCALE = 0.08838834764831845f;
    LAS float* kml = (LAS float*)(lds + AT_KML); LAS float* bl = (LAS float*)(lds + AT_BL);
#pragma unroll 1
    for (int u = blockIdx.x; u < 256; u += G) {
        asm volatile("" : "+v"(tid));
        const int lane = tid & 63, wave = tid >> 6, ql = lane & 31, hi = lane >> 5;
        const int bh = u >> 3, pp = u & 7, b = bh >> 3, h = bh & 7;
        __syncthreads();
        for (int i = tid; i < 2048; i += 512) kml[i] = KMEAN[(size_t)bh * 2048 + i];
        if (tid < 128) bl[tid] = rel_bias[(int)T5_BUCKET[tid] * 8 + h] * LOG2E;
        float bmax = rel_bias[h];
        for (int k = 1; k < 32; ++k) bmax = fmaxf(bmax, rel_bias[k * 8 + h]);
        float kn2 = __uint_as_float(KN[bh * 16]);
        for (int k = 1; k < 16; ++k) kn2 = fmaxf(kn2, __uint_as_float(KN[bh * 16 + k]));
        const float knmax = sqrtf(kn2);
        const float cfar_b = rel_bias[31 * 8 + h] * LOG2E;
        __syncthreads();
#pragma unroll 1
        for (int half = 0; half < 2; ++half) {
            asm volatile("" : "+v"(tid));
            const int lane = tid & 63, wave = tid >> 6, ql = lane & 31, hi = lane >> 5;
            const int qb = half == 0 ? pp : 15 - pp;
            const int qi = wave * 32 + ql;
            const size_t qrow = (size_t)b * 4096 + qb * 256 + qi;
            bf16x8v qf[8];
#pragma unroll
            for (int dd = 0; dd < 8; ++dd) qf[dd] = *(const bf16x8v*)(QK + qrow * 2048 + h * 128 + dd * 16 + hi * 8);
            float qn2 = 0.f; float gate[16];
#pragma unroll
            for (int j = 0; j < 16; ++j) gate[j] = 0.f;
#pragma unroll
            for (int dd = 0; dd < 8; ++dd) {
                float qv[8];
#pragma unroll
                for (int e = 0; e < 8; ++e) { qv[e] = __builtin_bit_cast(float, (unsigned)(unsigned short)qf[dd][e] << 16); qn2 += qv[e] * qv[e]; }
#pragma unroll
                for (int j = 0; j < 15; ++j) if (j < qb) { const LAS float* kp = kml + j * 128 + dd * 16 + hi * 8; const f32x4 k0 = *(const LAS f32x4*)kp, k1 = *(const LAS f32x4*)(kp + 4);
                    gate[j] += qv[0] * k0.x + qv[1] * k0.y + qv[2] * k0.z + qv[3] * k0.w + qv[4] * k1.x + qv[5] * k1.y + qv[6] * k1.z + qv[7] * k1.w; }
            }
            qn2 += shx(qn2, 32, lane);
            unsigned sel = 1u << qb;
            if (qb <= 3) sel |= (1u << qb) - 1u;
            else {
#pragma unroll
                for (int j = 0; j < 15; ++j) gate[j] += shx(gate[j], 32, lane);
#pragma unroll
                for (int r = 0; r < 3; ++r) { float best = -__builtin_inff(); int bi = 0;
#pragma unroll
                    for (int j = 0; j < 15; ++j) { const bool ok = (j < qb) && !((sel >> j) & 1u) && (gate[j] > best); best = ok ? gate[j] : best; bi = ok ? j : bi; }
                    sel |= 1u << bi; }
            }
            const float negm = -LOG2E * (SCALE * sqrtf(qn2) * knmax + bmax);
            const float c1 = SCALE * LOG2E, cfar = cfar_b + negm;
            f32x16 oacc[4];
#pragma unroll
            for (int dt = 0; dt < 4; ++dt)
#pragma unroll
                for (int i = 0; i < 16; ++i) oacc[dt][i] = 0.f;
            float lsum = 0.f;
#pragma unroll 1
            for (int j = 0; j <= qb; ++j) {
                __syncthreads();
                { int tl = tid; asm volatile("" : "+v"(tl));
                  const bf16* kg = QK + ((size_t)b * 4096 + j * 256) * 2048 + 1024 + h * 128;
#pragma unroll
                  for (int i = 0; i < 8; ++i) { const int c = tl + i * 512, r = c >> 4, cc = c & 15; const v4u v = *(const v4u*)(kg + (size_t)r * 2048 + cc * 8); *(LAS v4u*)(lds + AT_KS + r * AT_KROW + cc * 16) = v; }
                  const bf16* vg = VT + (size_t)(h * 128) * M + (size_t)b * 4096 + j * 256;
#pragma unroll
                  for (int i = 0; i < 8; ++i) { const int c = tl + i * 512, r = c >> 5, cc = c & 31, odd = cc & 1; const v4u v = *(const v4u*)(vg + (size_t)r * M + cc * 8);
                      LAS unsigned char* dst = lds + AT_VS + r * AT_VROW + (cc >> 1) * 32; v2u lo2, hi2; lo2.x = v.x; lo2.y = v.y; hi2.x = v.z; hi2.y = v.w;
                      *(LAS v2u*)(dst + (odd ? 8 : 0)) = lo2; *(LAS v2u*)(dst + (odd ? 24 : 16)) = hi2; } }
                __syncthreads();
                const float rs = ((sel >> j) & 1u) ? 1.f : 0.f;
                if (j == qb) attn_block<2>(lds, qf, oacc, lsum, ql, hi, qi, c1, cfar, negm, rs);
                else if (j == qb - 1) attn_block<1>(lds, qf, oacc, lsum, ql, hi, qi, c1, cfar, negm, rs);
                else attn_block<0>(lds, qf, oacc, lsum, ql, hi, qi, c1, cfar, negm, rs);
            }
            lsum += shx(lsum, 32, lane);
            const float inv = 1.f / lsum;
            bf16* orow = O + qrow * 1024 + h * 128;
#pragma unroll
            for (int dt = 0; dt < 4; ++dt)
#pragma unroll
                for (int g4 = 0; g4 < 4; ++g4) { v2u w; w.x = cvtpk(oacc[dt][4 * g4] * inv, oacc[dt][4 * g4 + 1] * inv); w.y = cvtpk(oacc[dt][4 * g4 + 2] * inv, oacc[dt][4 * g4 + 3] * inv);
                    *(v2u*)(orow + dt * 32 + 8 * g4 + 4 * hi) = w; }
        }
    }
}
__global__ void __launch_bounds__(512, 2) fwd_megakernel(Args a) {
    extern __shared__ __attribute__((aligned(16))) unsigned char lds_raw[];
    cg::grid_group grid = cg::this_grid();
    LAS unsigned char* lds = (LAS unsigned char*)lds_raw;
    const int G = gridDim.x, bx = blockIdx.x, NGW = G * 8, NT = G * 512;
#define LAUNDER_TID() int tid = threadIdx.x; asm volatile("" : "+v"(tid)); const int lane = tid & 63, wave = __builtin_amdgcn_readfirstlane(tid >> 6), gw = bx * 8 + wave, gt = bx * 512 + tid; (void)lane; (void)gw; (void)gt;
    unsigned char* ws = a.ws;
    bf16* XB = (bf16*)(ws + WS_XB); float* Y = (float*)(ws + WS_Y); bf16* HB = (bf16*)(ws + WS_HB); unsigned char* mx = ws + WS_MX;
    float* X = a.out;

    { LAUNDER_TID(); p0_prologue(a, lds, gw, NGW, wave, lane); }
    grid.sync();

#pragma unroll 1
    for (int st = 0; st < 12; ++st) {
        LAUNDER_TID();
        const int layer = st / 3, sub = st - layer * 3;
        const float* Xin = (st == 0) ? a.x : X;
        const bf16* Aop; const bf16* Bt; int K; float cmul;
        if (sub != 1) {
            const int fi = layer * 2 + (sub == 2 ? 1 : 0);
            { pg8::Gemm g{XB, (const bf16*)(ws + WS_WGU + fi * SZ_WGU), M, 2 * FF, D}; pg8::StaticOrder S; S.init(M, 2 * FF, G, bx);
              pg8::EpiSwiglu E{HB, FF};
              pg8::gemm_phase<pg8::EpiSwiglu, pg8::StaticOrder, true, true>(lds, g, S, E); }
            grid.sync();
            Aop = HB; Bt = (const bf16*)(ws + WS_WD + fi * SZ_WD); K = FF; cmul = 0.5f;
        } else {
            const int kind = layer % 3, j = layer / 3;
            if (kind == 0) {
                bf16* QK = (bf16*)(mx + MX_QK); bf16* VT = (bf16*)(mx + MX_VT); bf16* O = (bf16*)(mx + MX_O); float* KMEAN = (float*)(mx + MX_KMEAN); unsigned* KN = (unsigned*)(mx + MX_KN);
                const bf16* Win = (const bf16*)(ws + WS_AIN + j * SZ_AIN);
                { pg8::Gemm g{XB, Win, M, 2048, D}; pg8::StaticOrder S; S.init(M, 2048, G, bx); pg8::EpiBf16 E{QK, 2048};
                  pg8::gemm_phase<pg8::EpiBf16, pg8::StaticOrder, true, true>(lds, g, S, E); }
                { pg8::Gemm g{Win + (size_t)2048 * 1024, XB, 1024, M, D}; pg8::StaticOrder S; S.init(1024, M, G, bx); pg8::EpiBf16 E{VT, M};
                  pg8::gemm_phase<pg8::EpiBf16, pg8::StaticOrder, true, true>(lds, g, S, E); }
                grid.sync();
                kmean_phase(QK, KMEAN, KN, lds, tid, G);
                grid.sync();
                attn_mfma_phase(QK, VT, KMEAN, KN, a.rel_bias, O, lds, tid, G);
                grid.sync();
                Aop = O; Bt = (const bf16*)(ws + WS_AOUT + j * SZ_SQ); K = D; cmul = 1.0f;
            } else if (kind == 1) {
                bf16* U = (bf16*)(mx + MX_U); bf16* P = (bf16*)(mx + MX_P);
                { pg8::Gemm g{XB, (const bf16*)(ws + WS_BIN), M, D, D}; pg8::StaticOrder S; S.init(M, D, G, bx); pg8::EpiBf16 E{U, D};
                  pg8::gemm_phase<pg8::EpiBf16, pg8::StaticOrder, true, true>(lds, g, S, E); }
                grid.sync();
                pool_phase(U, P, gt, NT);
                grid.sync();
                Aop = P; Bt = (const bf16*)(ws + WS_BCOMB); K = D; cmul = 1.0f;
            } else {
                bf16* PROJ = (bf16*)(mx + MX_PROJ); bf16* QC = (bf16*)(mx + MX_QC); bf16* KC = (bf16*)(mx + MX_KC); float* HT = (float*)(mx + MX_HT); float* GATES = (float*)(mx + MX_GATES); bf16* HN = (bf16*)(mx + MX_HN2);
                { pg8::Gemm g{XB, (const bf16*)(ws + WS_CIN), M, 4096, D}; pg8::StaticOrder S; S.init(M, 4096, G, bx); pg8::EpiBf16 E{PROJ, 4096};
                  pg8::gemm_phase<pg8::EpiBf16, pg8::StaticOrder, true, true>(lds, g, S, E); }
                gates_phase(Xin, a.c_w_in, a.c_b_gates, GATES, gw, NGW, lane);
                grid.sync();
                conv_phase(PROJ, a.c_conv_w, QC, KC, gt, NT);
                grid.sync();
                mlstm_valu_phase(QC, KC, PROJ, GATES, HT, lds, tid, G);
                grid.sync();
                headnorm_phase(HT, PROJ, a.c_norm_g, HN, gw, NGW, lane);
                grid.sync();
                Aop = HN; Bt = (const bf16*)(ws + WS_COUT); K = D; cmul = 1.0f;
            }
        }
        { pg8::Gemm g{Aop, Bt, M, D, K}; pg8::StaticOrder S; S.init(M, D, G, bx); pg8::EpiPreLN E{Xin, Y, ALPHA, cmul};
          pg8::gemm_phase<pg8::EpiPreLN, pg8::StaticOrder, true, true>(lds, g, S, E); }
        grid.sync();
        ln_phase(Y, a.ln_g + (size_t)st * D, a.ln_b + (size_t)st * D, X, XB, gw, NGW, lane);
        grid.sync();
    }
}

extern "C" void kernel_launch(void* const* d_in, const int* in_sizes, int n_in, void* d_out, int out_size, void* d_ws, size_t ws_size, hipStream_t stream) {
    static int grid = 0;
    if (grid == 0) {
        if (n_in != 17 || out_size != M * D || ws_size < WS_END) { fprintf(stderr, "kernel_launch: unexpected shapes (n_in %d out %d ws %zu need %zu)\n", n_in, out_size, ws_size, (size_t)WS_END); grid = -1; return; }
        int dev = 0, cus = 0, per_cu = 0;
        (void)hipGetDevice(&dev); (void)hipDeviceGetAttribute(&cus, hipDeviceAttributeMultiprocessorCount, dev);
        if (hipFuncSetAttribute((const void*)fwd_megakernel, hipFuncAttributeMaxDynamicSharedMemorySize, LDS_BYTES) != hipSuccess) { fprintf(stderr, "kernel_launch: hipFuncSetAttribute failed\n"); grid = -1; return; }
        if (hipOccupancyMaxActiveBlocksPerMultiprocessor(&per_cu, (const void*)fwd_megakernel, 512, LDS_BYTES) != hipSuccess || per_cu < 1) { fprintf(stderr, "kernel_launch: occupancy query gives %d\n", per_cu); per_cu = 1; }
        (void)hipGetLastError();
        grid = cus * 1;
    }
    if (grid < 0) return;
    Args a{};
    a.x = (const float*)d_in[0]; a.rel_bias = (const float*)d_in[1]; a.ln_g = (const float*)d_in[2]; a.ln_b = (const float*)d_in[3];
    a.ffn_w_gu = (const float*)d_in[4]; a.ffn_w_down = (const float*)d_in[5]; a.a_w_in = (const float*)d_in[6]; a.a_w_out = (const float*)d_in[7];
    a.b_w_in = (const float*)d_in[8]; a.b_w_group = (const float*)d_in[9]; a.b_scale = (const float*)d_in[10]; a.b_w_out = (const float*)d_in[11];
    a.c_w_in = (const float*)d_in[12]; a.c_b_gates = (const float*)d_in[13]; a.c_conv_w = (const float*)d_in[14]; a.c_norm_g = (const float*)d_in[15]; a.c_w_out = (const float*)d_in[16];
    a.out = (float*)d_out; a.ws = (unsigned char*)d_ws;
    void* args[] = {&a};
    hipError_t e = hipLaunchCooperativeKernel((const void*)fwd_megakernel, dim3(grid), dim3(512), args, LDS_BYTES, stream);
    if (e != hipSuccess) fprintf(stderr, "kernel_launch: cooperative launch failed: %s (grid %d)\n", hipGetErrorString(e), grid);
}
```

```cpp
#include <hip/hip_runtime.h>
#include <hip/hip_cooperative_groups.h>
#include <cstdio>
#include <cstdint>
namespace cg = cooperative_groups;
namespace pg8 {
#define PG8_LAS __attribute__((address_space(3)))
typedef unsigned short bf16_t;
typedef short bf16x8 __attribute__((ext_vector_type(8)));
typedef float f32x4 __attribute__((ext_vector_type(4)));
typedef unsigned u32x4 __attribute__((ext_vector_type(4)));
constexpr int BM = 256, BK = 64, HALF = 128, HTB = HALF * BK * 2  , STAGE_BYTES = 8 * HTB, NXCD = 8, WGM = 8;

__host__ __device__ __forceinline__ int lds_byte(int r, int c) { const int st = (r >> 4) * 2 + (c >> 5), rr = r & 15, cc = c & 31, ob = rr * 64 + cc * 2; return st * 1024 + (ob ^ (((ob >> 9) & 1) << 5)); }
__host__ __device__ __forceinline__ void stage_rc(int b, int& R, int& C) { const int st = b / 1024, sb = b % 1024, swz = sb ^ (((sb >> 9) & 1) << 5); R = (st >> 1) * 16 + swz / 64; C = (st & 1) * 32 + (swz % 64) / 2; }
__host__ __device__ __forceinline__ int perm32(int rho) { const int n = rho >> 4, i = rho & 15; return 8 * (i >> 2) + 4 * n + (i & 3); }

struct Unit { int pm, pn; };
struct Gemm { const bf16_t* A; const bf16_t* Bt; int M, N, K; };

struct StaticOrder {
    int nM, nN, nwg, G, c;
    __host__ __device__ void init(int M, int N, int G_, int c_) { nM = M / BM; nN = N / BM; nwg = nM * nN; G = G_; c = c_; }
    __host__ __device__ bool next(int i, Unit& u) const {
        const long L = (long)i * G + c; if (L >= nwg) return false;
        int wgid = (int)L; { const int q = nwg / NXCD, r = nwg % NXCD, xcd = wgid % NXCD, off = wgid / NXCD; wgid = (xcd < r ? xcd * (q + 1) : r * (q + 1) + (xcd - r) * q) + off; }
        const int nig = WGM * nN, gid = wgid / nig, fm = gid * WGM, gsz = (nM - fm) < WGM ? (nM - fm) : WGM;
        u.pm = fm + ((wgid % nig) % gsz); u.pn = (wgid % nig) / gsz; return true;
    }
    __device__ __forceinline__ void a_ready(const Unit&) const {}
    __device__ __forceinline__ void done(const Unit&) const {}
};

__device__ __forceinline__ unsigned cvt_pk_bf16(float lo, float hi) { unsigned r; asm volatile("v_cvt_pk_bf16_f32 %0, %1, %2" : "=v"(r) : "v"(lo), "v"(hi)); return r; }
struct EpiBf16 {
    static constexpr bool PERM = true, AFTER_DRAIN = false;
    bf16_t* O; int ldc;
    __device__ __forceinline__ void operator()(const f32x4 (&acc)[2][2][4][2], const Unit& u, int wr, int wc, int fr, int fq) const {
        const int row0 = u.pm * BM + wr * 64 + fr; const int col0 = u.pn * BM + wc * 32 + 8 * fq;
#pragma unroll
        for (int ai = 0; ai < 2; ++ai)
#pragma unroll
            for (int m = 0; m < 4; ++m) { bf16_t* rowp = O + (size_t)(row0 + ai * HALF + m * 16) * ldc + col0;
#pragma unroll
                for (int bj = 0; bj < 2; ++bj) { const f32x4 v0 = acc[ai][bj][m][0], v1 = acc[ai][bj][m][1];
                    u32x4 w; w.x = cvt_pk_bf16(v0[0], v0[1]); w.y = cvt_pk_bf16(v0[2], v0[3]); w.z = cvt_pk_bf16(v1[0], v1[1]); w.w = cvt_pk_bf16(v1[2], v1[3]);
                    *(u32x4*)(rowp + bj * HALF) = w; } }
    }
};
__device__ __forceinline__ float silu_f(float g) { return g * __builtin_amdgcn_rcpf(1.0f + __builtin_amdgcn_exp2f(-1.44269504089f * g)); }
struct EpiSwiglu {
    static constexpr bool PERM = true, AFTER_DRAIN = false;
    bf16_t* O; int ldc;
    __device__ __forceinline__ void operator()(const f32x4 (&acc)[2][2][4][2], const Unit& u, int wr, int wc, int fr, int fq) const {
        const int row0 = u.pm * BM + wr * 64 + fr; const int col0 = u.pn * HALF + wc * 32 + 8 * fq;
#pragma unroll
        for (int ai = 0; ai < 2; ++ai)
#pragma unroll
            for (int m = 0; m < 4; ++m) { bf16_t* rowp = O + (size_t)(row0 + ai * HALF + m * 16) * ldc + col0;
                const f32x4 g0 = acc[ai][0][m][0], g1 = acc[ai][0][m][1], u0 = acc[ai][1][m][0], u1 = acc[ai][1][m][1];
                u32x4 w;
                w.x = cvt_pk_bf16(silu_f(g0[0]) * u0[0], silu_f(g0[1]) * u0[1]); w.y = cvt_pk_bf16(silu_f(g0[2]) * u0[2], silu_f(g0[3]) * u0[3]);
                w.z = cvt_pk_bf16(silu_f(g1[0]) * u1[0], silu_f(g1[1]) * u1[1]); w.w = cvt_pk_bf16(silu_f(g1[2]) * u1[2], silu_f(g1[3]) * u1[3]);
                *(u32x4*)rowp = w; }
    }
};
struct EpiPreLN {
    static constexpr bool PERM = false, AFTER_DRAIN = false;
    const float* X; float* Y; float alpha, c;
    __device__ __forceinline__ void operator()(const f32x4 (&acc)[2][2][4][2], const Unit& u, int wr, int wc, int fr, int fq) const {
        const int row0 = u.pm * BM + wr * 64 + fr; const int col0 = u.pn * BM + wc * 32 + 4 * fq;
#pragma unroll
        for (int ai = 0; ai < 2; ++ai)
#pragma unroll
            for (int m = 0; m < 4; ++m) { const size_t off = (size_t)(row0 + ai * HALF + m * 16) * 1024 + col0;
#pragma unroll
                for (int bj = 0; bj < 2; ++bj)
#pragma unroll
                    for (int n = 0; n < 2; ++n) { const f32x4 xv = *(const f32x4*)(X + off + bj * HALF + n * 16);
                        *(f32x4*)(Y + off + bj * HALF + n * 16) = xv * alpha + acc[ai][bj][m][n] * c; } }
    }
};
template <class Epi, class Sched, bool ALIGN_EPI = false, bool SP2 = false>
__device__ __forceinline__ void gemm_phase(PG8_LAS unsigned char* lds, const Gemm g, const Sched& S, const Epi& E) {
    int tid_raw = threadIdx.x; asm volatile("" : "+v"(tid_raw));
    const int tid = tid_raw, wid = __builtin_amdgcn_readfirstlane(tid >> 6), lane = tid & 63, wr = wid >> 2, wc = wid & 3, fr = lane & 15, fq = lane >> 4;
    const int K = g.K, nt = K / BK;
    unsigned voffA[2], voffB[2];
#pragma unroll
    for (int i = 0; i < 2; ++i) { int R, C; stage_rc(tid * 16 + i * 8192, R, C); const int Rb = Epi::PERM ? ((R & ~31) + perm32(R & 31)) : R;
        voffA[i] = (unsigned)(R * K + C) * 2u; voffB[i] = (unsigned)(Rb * K + C) * 2u; }
    const size_t kstep = (size_t)(BK * 2);
    const size_t hstep = (size_t)HALF * K * 2;
    const size_t tstep = 2 * hstep;
    const unsigned ldsw = (unsigned)wid * 1024u;
    const int aoff = lds_byte(wr * 64 + fr, fq * 8), boff = lds_byte(wc * 32 + fr, fq * 8);
#define PG8_SA(b, h) (((b) * 2 + (h)) * HTB)
#define PG8_SB(b, h) ((4 + (b) * 2 + (h)) * HTB)
#define PG8_STAGE(bufoff, gbase, voff) do { _Pragma("unroll") for (int _i = 0; _i < 2; ++_i) \
        __builtin_amdgcn_global_load_lds((const unsigned*)((const char*)(gbase) + (voff)[_i]), (PG8_LAS unsigned*)(lds + (bufoff) + ldsw + _i * 8192), 16, 0, 0); } while (0)
#define PG8_LDA(dst, b, h) do { _Pragma("unroll") for (int m = 0; m < 4; ++m) _Pragma("unroll") for (int k = 0; k < 2; ++k) dst[m][k] = *(const PG8_LAS bf16x8*)(lds + PG8_SA(b, h) + aoff + m * 2048 + k * 1024); } while (0)
#define PG8_LDB(dst, b, h) do { _Pragma("unroll") for (int n = 0; n < 2; ++n) _Pragma("unroll") for (int k = 0; k < 2; ++k) dst[n][k] = *(const PG8_LAS bf16x8*)(lds + PG8_SB(b, h) + boff + n * 2048 + k * 1024); } while (0)
#define PG8_MMA(ai, bj, At, Bt) do { __builtin_amdgcn_s_setprio(1); _Pragma("unroll") for (int m = 0; m < 4; ++m) _Pragma("unroll") for (int n = 0; n < 2; ++n) _Pragma("unroll") for (int k = 0; k < 2; ++k) \
        acc[ai][bj][m][n] = __builtin_amdgcn_mfma_f32_16x16x32_bf16(Bt[n][k], At[m][k], acc[ai][bj][m][n], 0, 0, 0); __builtin_amdgcn_s_setprio(0); } while (0)
#define PG8_WAIT_V(n) asm volatile("s_waitcnt vmcnt(" #n ")" ::: "memory")
#define PG8_WAIT_L(n) asm volatile("s_waitcnt lgkmcnt(" #n ")" ::: "memory")
#define PG8_BAR __builtin_amdgcn_s_barrier()
#define PG8_SCHED __builtin_amdgcn_sched_barrier(0)
    Unit cur, nxt; int ui = 0;
    if (!S.next(0, cur)) return;
    f32x4 acc[2][2][4][2];
#pragma unroll
    for (int a = 0; a < 2; ++a)
#pragma unroll
        for (int b = 0; b < 2; ++b)
#pragma unroll
            for (int m = 0; m < 4; ++m)
#pragma unroll
                for (int n = 0; n < 2; ++n) acc[a][b][m][n] = (f32x4){0.f, 0.f, 0.f, 0.f};
    bf16x8 At[4][2], B0[2][2], B1[2][2];
    const char* cA = (const char*)g.A + (size_t)cur.pm * tstep; const char* cB = (const char*)g.Bt + (size_t)cur.pn * tstep;
    S.a_ready(cur);
    if constexpr (SP2) {
        PG8_STAGE(PG8_SB(0, 0), cB, voffB); PG8_STAGE(PG8_SB(0, 1), cB + hstep, voffB); PG8_STAGE(PG8_SA(0, 0), cA, voffA); PG8_STAGE(PG8_SA(0, 1), cA + hstep, voffA);
        if (wr == 1) PG8_BAR;
        PG8_WAIT_V(2); PG8_BAR;
        PG8_STAGE(PG8_SB(1, 0), cB + kstep, voffB); PG8_STAGE(PG8_SA(1, 0), cA + kstep, voffA); PG8_STAGE(PG8_SB(1, 1), cB + hstep + kstep, voffB);
        PG8_WAIT_V(6); PG8_BAR;
    } else {
        PG8_STAGE(PG8_SB(0, 0), cB, voffB); PG8_STAGE(PG8_SA(0, 0), cA, voffA); PG8_STAGE(PG8_SB(0, 1), cB + hstep, voffB); PG8_STAGE(PG8_SA(0, 1), cA + hstep, voffA);
        if (wr == 1) PG8_BAR;
        PG8_WAIT_V(4); PG8_BAR;
        PG8_STAGE(PG8_SB(1, 0), cB + kstep, voffB); PG8_STAGE(PG8_SA(1, 0), cA + kstep, voffA); PG8_STAGE(PG8_SB(1, 1), cB + hstep + kstep, voffB);
        PG8_WAIT_V(6); PG8_BAR;
    }
    for (;;) {
        const bool has_next = S.next(ui + 1, nxt);
        const char* nA = has_next ? (const char*)g.A + (size_t)nxt.pm * tstep : cA; const char* nB = has_next ? (const char*)g.Bt + (size_t)nxt.pn * tstep : cB;
        for (int t = 0; t < nt; t += 2) {
            const bool last = (t == nt - 2);
            const char* a1 = cA + (size_t)(t + 1) * kstep;
            const char* a2 = last ? nA : cA + (size_t)(t + 2) * kstep; const char* b2 = last ? nB : cB + (size_t)(t + 2) * kstep;
            const char* a3 = a2 + kstep; const char* b3 = b2 + kstep;
            if (last && has_next) S.a_ready(nxt);
            if constexpr (SP2) {
            PG8_LDB(B0, 0, 0); PG8_LDB(B1, 0, 1); PG8_SCHED; PG8_LDA(At, 0, 0); PG8_STAGE(PG8_SA(1, 1), a1 + hstep, voffA);
            PG8_WAIT_V(8); PG8_WAIT_L(0); PG8_BAR; PG8_MMA(0, 0, At, B0); PG8_MMA(0, 1, At, B1); PG8_BAR; PG8_SCHED;
            PG8_LDA(At, 0, 1); PG8_STAGE(PG8_SB(0, 0), b2, voffB); PG8_STAGE(PG8_SB(0, 1), b2 + hstep, voffB); PG8_STAGE(PG8_SA(0, 0), a2, voffA);
            PG8_WAIT_V(8); PG8_WAIT_L(0); PG8_BAR; PG8_MMA(1, 0, At, B0); PG8_MMA(1, 1, At, B1); PG8_BAR; PG8_SCHED;
            PG8_LDB(B0, 1, 0); PG8_LDB(B1, 1, 1); PG8_SCHED; PG8_LDA(At, 1, 0); PG8_STAGE(PG8_SA(0, 1), a2 + hstep, voffA);
            PG8_WAIT_V(8); PG8_WAIT_L(0); PG8_BAR; PG8_MMA(0, 0, At, B0); PG8_MMA(0, 1, At, B1); PG8_BAR; PG8_SCHED;
            PG8_LDA(At, 1, 1); PG8_STAGE(PG8_SB(1, 0), b3, voffB); PG8_STAGE(PG8_SB(1, 1), b3 + hstep, voffB); PG8_STAGE(PG8_SA(1, 0), a3, voffA);
            PG8_WAIT_V(8); PG8_WAIT_L(0); PG8_BAR; PG8_MMA(1, 0, At, B0); PG8_MMA(1, 1, At, B1); PG8_BAR; PG8_SCHED;
            } else {
            PG8_LDB(B0, 0, 0); PG8_SCHED; PG8_LDA(At, 0, 0); PG8_STAGE(PG8_SA(1, 1), a1 + hstep, voffA);
            PG8_WAIT_L(8); PG8_BAR; PG8_WAIT_L(0); PG8_MMA(0, 0, At, B0); PG8_BAR; PG8_SCHED;
            PG8_LDB(B1, 0, 1); PG8_STAGE(PG8_SB(0, 0), b2, voffB);
            PG8_BAR; PG8_WAIT_L(0); PG8_MMA(0, 1, At, B1); PG8_BAR;
            PG8_LDA(At, 0, 1); PG8_STAGE(PG8_SA(0, 0), a2, voffA);
            PG8_BAR; PG8_WAIT_L(0); PG8_MMA(1, 0, At, B0); PG8_BAR; PG8_SCHED;
            PG8_STAGE(PG8_SB(0, 1), b2 + hstep, voffB);
            PG8_WAIT_V(6); PG8_BAR; PG8_MMA(1, 1, At, B1); PG8_BAR;
            PG8_LDB(B0, 1, 0); PG8_SCHED; PG8_LDA(At, 1, 0); PG8_STAGE(PG8_SA(0, 1), a2 + hstep, voffA);
            PG8_WAIT_L(8); PG8_BAR; PG8_WAIT_L(0); PG8_MMA(0, 0, At, B0); PG8_BAR; PG8_SCHED;
            PG8_LDB(B1, 1, 1); PG8_STAGE(PG8_SB(1, 0), b3, voffB);
            PG8_BAR; PG8_WAIT_L(0); PG8_MMA(0, 1, At, B1); PG8_BAR;
            PG8_LDA(At, 1, 1); PG8_STAGE(PG8_SA(1, 0), a3, voffA);
            PG8_BAR; PG8_WAIT_L(0); PG8_MMA(1, 0, At, B0); PG8_BAR; PG8_SCHED;
            PG8_STAGE(PG8_SB(1, 1), b3 + hstep, voffB);
            PG8_WAIT_V(6); PG8_BAR; PG8_MMA(1, 1, At, B1); PG8_BAR;
            }
        }
        if constexpr (ALIGN_EPI) { if (wr == 0) PG8_BAR; }
        if constexpr (!Epi::AFTER_DRAIN) { E(acc, cur, wr, wc, fr, fq); S.done(cur); }
        if (!has_next) break;
#pragma unroll
        for (int a = 0; a < 2; ++a)
#pragma unroll
            for (int b = 0; b < 2; ++b)
#pragma unroll
                for (int m = 0; m < 4; ++m)
#pragma unroll
                    for (int n = 0; n < 2; ++n) acc[a][b][m][n] = (f32x4){0.f, 0.f, 0.f, 0.f};
        cur = nxt; cA = nA; cB = nB; ++ui;
        if constexpr (ALIGN_EPI) { if (wr == 1) PG8_BAR; }
    }
    PG8_WAIT_V(0);
    if constexpr (!ALIGN_EPI) { if (wr == 0) PG8_BAR; }
    PG8_BAR;
    if constexpr (Epi::AFTER_DRAIN) { E.fused(acc, cur, wr, wc, fr, fq, lds, wid, lane); S.done(cur); }
#undef PG8_SA
#undef PG8_SB
#undef PG8_STAGE
#undef PG8_LDA
#undef PG8_LDB
#undef PG8_MMA
#undef PG8_WAIT_V
#undef PG8_WAIT_L
#undef PG8_BAR
#undef PG8_SCHED
}
}
#define LAS __attribute__((address_space(3)))
typedef unsigned short bf16;
typedef float f32x4 __attribute__((ext_vector_type(4)));
typedef unsigned v4u __attribute__((ext_vector_type(4)));
typedef unsigned v2u __attribute__((ext_vector_type(2)));
constexpr int M = 16384, D = 1024, FF = 2816, SEQ = 4096, NB = 4;
constexpr float LN_EPS = 1e-5f;
constexpr float ALPHA = 1.6817928305074290f;
constexpr size_t MiB = 1u << 20;
constexpr size_t WS_CTL = 0;
constexpr size_t WS_WGU = 1 * MiB;
constexpr size_t SZ_WGU = (size_t)5632 * 1024 * 2;
constexpr size_t WS_WD = WS_WGU + 8 * SZ_WGU;
constexpr size_t SZ_WD = (size_t)1024 * 2816 * 2;
constexpr size_t WS_AIN = WS_WD + 8 * SZ_WD;
constexpr size_t SZ_AIN = (size_t)3072 * 1024 * 2;
constexpr size_t SZ_SQ = (size_t)1024 * 1024 * 2;
constexpr size_t WS_AOUT = WS_AIN + 2 * SZ_AIN;
constexpr size_t WS_BIN = WS_AOUT + 2 * SZ_SQ;
constexpr size_t WS_BCOMB = WS_BIN + SZ_SQ;
constexpr size_t WS_CIN = WS_BCOMB + SZ_SQ;
constexpr size_t WS_COUT = WS_CIN + 4 * SZ_SQ;
constexpr size_t WS_XB = WS_COUT + SZ_SQ;
constexpr size_t WS_Y = WS_XB + (size_t)M * D * 2;
constexpr size_t WS_HB = WS_Y + (size_t)M * D * 4;
constexpr size_t WS_MX = WS_HB + (size_t)M * FF * 2;
constexpr size_t WS_END = WS_MX + 290 * MiB;
constexpr size_t MX_QK = 0, MX_VT = 64 * MiB, MX_O = 96 * MiB, MX_KMEAN = 128 * MiB, MX_KN = 129 * MiB;
constexpr size_t MX_U = 0, MX_P = 32 * MiB;
constexpr size_t MX_QKP = 0, MX_KVT = 64 * MiB, MX_OP = 128 * MiB, MX_QC = 160 * MiB, MX_KC = 192 * MiB, MX_KT = 224 * MiB, MX_GATES = 256 * MiB, MX_HN2 = 257 * MiB  ;

constexpr int LDS_BYTES = 147456;

__device__ const unsigned char T5_BUCKET[128] = {0, 1, 2, 3, 4, 5, 6, 7, 8, 9, 10, 11, 12, 13, 14, 15, 16, 16, 16, 17, 17, 18, 18, 18, 19, 19, 19, 20, 20, 20, 20, 21, 21, 21, 21, 22, 22, 22, 22, 22, 23, 23, 23, 23, 23, 23, 24, 24, 24, 24, 24, 24, 25, 25, 25, 25, 25, 25, 25, 26, 26, 26, 26, 26, 26, 26, 26, 27, 27, 27, 27, 27, 27, 27, 27, 27, 27, 28, 28, 28, 28, 28, 28, 28, 28, 28, 28, 29, 29, 29, 29, 29, 29, 29, 29, 29, 29, 29, 29, 30, 30, 30, 30, 30, 30, 30, 30, 30, 30, 30, 30, 30, 30, 31, 31, 31, 31, 31, 31, 31, 31, 31, 31, 31, 31, 31, 31, 31};

__device__ __forceinline__ unsigned f2bf(float f) { unsigned u = __builtin_bit_cast(unsigned, f); return (u + 0x7fffu + ((u >> 16) & 1u)) >> 16; }
__device__ __forceinline__ unsigned pk2(float lo, float hi) { return f2bf(lo) | (f2bf(hi) << 16); }
__device__ __forceinline__ float bf_lo(unsigned w) { return __builtin_bit_cast(float, w << 16); }
__device__ __forceinline__ float bf_hi(unsigned w) { return __builtin_bit_cast(float, w & 0xffff0000u); }
__device__ __forceinline__ float bf1(bf16 v) { return __builtin_bit_cast(float, (unsigned)v << 16); }
__device__ __forceinline__ float shx(float v, int o, int lane) { return __builtin_bit_cast(float, __builtin_amdgcn_ds_bpermute((lane ^ o) << 2, __builtin_bit_cast(int, v))); }
__device__ __forceinline__ float shidx(float v, int src) { return __builtin_bit_cast(float, __builtin_amdgcn_ds_bpermute(src << 2, __builtin_bit_cast(int, v))); }
__device__ __forceinline__ float wave_sum(float v, int lane) {
#pragma unroll
    for (int o = 1; o < 64; o <<= 1) v += shx(v, o, lane);
    return v;
}
__device__ __forceinline__ float wave_max(float v, int lane) {
#pragma unroll
    for (int o = 1; o < 64; o <<= 1) v = fmaxf(v, shx(v, o, lane));
    return v;
}
#define LDS_WAIT() asm volatile("s_waitcnt lgkmcnt(0)" ::: "memory")

struct Args {
    const float* x; const float* rel_bias; const float* ln_g; const float* ln_b; const float* ffn_w_gu; const float* ffn_w_down;
    const float* a_w_in; const float* a_w_out; const float* b_w_in; const float* b_w_group; const float* b_scale; const float* b_w_out;
    const float* c_w_in; const float* c_b_gates; const float* c_conv_w; const float* c_norm_g; const float* c_w_out;
    float* out; unsigned char* ws;
};

__device__ __forceinline__ void transpose_item(const float* W, int ldw, int K, bf16* WT, int k0, int n0, int drow0, LAS float* scr, int lane) {
#pragma unroll 8
    for (int i = 0; i < 32; ++i) { const int kk = 2 * i + (lane >> 5); scr[kk * 33 + (lane & 31)] = W[(size_t)(k0 + kk) * ldw + n0 + (lane & 31)]; }
    LDS_WAIT(); asm volatile("" ::: "memory");
    const int c = lane & 7;
#pragma unroll
    for (int j = 0; j < 4; ++j) { const int n = (lane >> 3) + 8 * j; const LAS float* s = scr + (8 * c) * 33 + n;
        v4u o; o.x = pk2(s[0 * 33], s[1 * 33]); o.y = pk2(s[2 * 33], s[3 * 33]); o.z = pk2(s[4 * 33], s[5 * 33]); o.w = pk2(s[6 * 33], s[7 * 33]);
        *(v4u*)(WT + (size_t)(drow0 + n) * K + k0 + 8 * c) = o; }
    LDS_WAIT(); asm volatile("" ::: "memory");
}
__device__ __forceinline__ void tr_plain(const float* W, int ldw, int K, int ncols, bf16* WT, int r, LAS float* scr, int lane) {
    const int nblk = ncols / 32, kb = r / nblk, nb = r % nblk;
    transpose_item(W, ldw, K, WT, 64 * kb, 32 * nb, 32 * nb, scr, lane);
}

__device__ __forceinline__ void p0_prologue(const Args& a, LAS unsigned char* lds, int gw, int NGW, int wave, int lane) {
    LAS float* scr = (LAS float*)(lds + wave * 16384);
    unsigned char* ws = a.ws;
    constexpr int I_GU = 16 * 176, I_DN = 44 * 32, I_AIN = 16 * 96, I_SQ = 16 * 32, I_CIN = 16 * 128;
    constexpr int NITEMS = 8 * I_GU + 8 * I_DN + 2 * I_AIN + 2 * I_SQ + I_SQ + I_CIN + I_SQ;
    for (int it = gw; it < NITEMS; it += NGW) {
        int r = it;
        if (r < 8 * I_GU) { const int mi = r / I_GU; r -= mi * I_GU; const int kb = r / 176, nb = r % 176, n0 = 32 * nb;
            const int drow0 = (n0 < FF) ? ((n0 >> 7) * 256 + (n0 & 127)) : ((((n0 - FF) >> 7) * 256) + 128 + ((n0 - FF) & 127));
            transpose_item(a.ffn_w_gu + (size_t)mi * 1024 * 5632, 5632, 1024, (bf16*)(ws + WS_WGU + mi * SZ_WGU), 64 * kb, n0, drow0, scr, lane); continue; }
        r -= 8 * I_GU;
        if (r < 8 * I_DN) { const int mi = r / I_DN; r -= mi * I_DN; tr_plain(a.ffn_w_down + (size_t)mi * 2816 * 1024, 1024, 2816, 1024, (bf16*)(ws + WS_WD + mi * SZ_WD), r, scr, lane); continue; }
        r -= 8 * I_DN;
        if (r < 2 * I_AIN) { const int mi = r / I_AIN; r -= mi * I_AIN; tr_plain(a.a_w_in + (size_t)mi * 1024 * 3072, 3072, 1024, 3072, (bf16*)(ws + WS_AIN + mi * SZ_AIN), r, scr, lane); continue; }
        r -= 2 * I_AIN;
        if (r < 2 * I_SQ) { const int mi = r / I_SQ; r -= mi * I_SQ; tr_plain(a.a_w_out + (size_t)mi * 1024 * 1024, 1024, 1024, 1024, (bf16*)(ws + WS_AOUT + mi * SZ_SQ), r, scr, lane); continue; }
        r -= 2 * I_SQ;
        if (r < I_SQ) { tr_plain(a.b_w_in, 1024, 1024, 1024, (bf16*)(ws + WS_BIN), r, scr, lane); continue; }
        r -= I_SQ;
        if (r < I_CIN) { tr_plain(a.c_w_in, 4104, 1024, 4096, (bf16*)(ws + WS_CIN), r, scr, lane); continue; }
        r -= I_CIN;
        tr_plain(a.c_w_out, 1024, 1024, 1024, (bf16*)(ws + WS_COUT), r, scr, lane);
    }
    {
        bf16* WT = (bf16*)(ws + WS_BCOMB);
        const int gt = gw * 64 + lane, NT = NGW * 64;
        for (int o = gt; o < 1024 * 1024; o += NT) {
            const int k = o >> 10, n = o & 1023, g = k >> 8;
            const float* wg = a.b_w_group + (size_t)k * 256; const float* sc = a.b_scale + g * 256; const float* wo = a.b_w_out + (size_t)(g * 256) * 1024 + n;
            float acc = 0.f;
#pragma unroll 8
            for (int d = 0; d < 256; ++d) acc += wg[d] * sc[d] * wo[(size_t)d * 1024];
            WT[(size_t)n * 1024 + k] = (bf16)f2bf(acc);
        }
    }
    {
        bf16* XB = (bf16*)(ws + WS_XB);
        const int gt = gw * 64 + lane, NT = NGW * 64;
        for (int o = gt; o < M * D / 8; o += NT) {
            const f32x4 v0 = ((const f32x4*)a.x)[2 * o], v1 = ((const f32x4*)a.x)[2 * o + 1];
            v4u w; w.x = pk2(v0.x, v0.y); w.y = pk2(v0.z, v0.w); w.z = pk2(v1.x, v1.y); w.w = pk2(v1.z, v1.w);
            ((v4u*)XB)[o] = w;
        }
    }
}

__device__ __forceinline__ void ln_phase(const float* Y, const float* g, const float* b, float* X, bf16* XB, int gw, int NGW, int lane) {
    f32x4 gv[4], bv[4];
#pragma unroll
    for (int j = 0; j < 4; ++j) { gv[j] = ((const f32x4*)g)[lane + 64 * j]; bv[j] = ((const f32x4*)b)[lane + 64 * j]; }
    for (int m = gw; m < M; m += NGW) {
        const f32x4* yr = (const f32x4*)(Y + (size_t)m * D) + lane;
        f32x4 v[4]; float s = 0.f;
#pragma unroll
        for (int j = 0; j < 4; ++j) { v[j] = yr[64 * j]; s += (v[j].x + v[j].y) + (v[j].z + v[j].w); }
        const float mean = wave_sum(s, lane) * (1.f / D); float s2 = 0.f;
#pragma unroll
        for (int j = 0; j < 4; ++j) { v[j] = v[j] - mean; s2 += (v[j].x * v[j].x + v[j].y * v[j].y) + (v[j].z * v[j].z + v[j].w * v[j].w); }
        const float rstd = 1.f / sqrtf(wave_sum(s2, lane) * (1.f / D) + LN_EPS);
        f32x4* xo = (f32x4*)(X + (size_t)m * D) + lane; v2u* bo = (v2u*)(XB + (size_t)m * D) + lane;
#pragma unroll
        for (int j = 0; j < 4; ++j) { const f32x4 o = v[j] * rstd * gv[j] + bv[j]; xo[64 * j] = o; v2u w; w.x = pk2(o.x, o.y); w.y = pk2(o.z, o.w); bo[64 * j] = w; }
    }
}
__device__ __forceinline__ void kmean_phase(const bf16* QK, float* KMEAN, unsigned* KN, LAS unsigned char* lds, int tid, int G) {
    LAS float* red = (LAS float*)lds;
    const int wave = tid >> 6, lane = tid & 63;
    for (int u = blockIdx.x; u < 512; u += G) {
        const int h = u & 7, j = (u >> 3) & 15, b = u >> 7;
        const bf16* kb = QK + (size_t)(b * 4096 + j * 256) * 2048 + 1024 + h * 128;
        const int d = tid & 127, rq = tid >> 7;
        float s = 0.f;
        for (int r = rq * 64; r < rq * 64 + 64; ++r) s += bf1(kb[(size_t)r * 2048 + d]);
        red[rq * 128 + d] = s;
        float mx = 0.f;
        for (int r = wave * 32; r < wave * 32 + 32; ++r) { const unsigned w = *(const unsigned*)(kb + (size_t)r * 2048 + 2 * lane); const float a = bf_lo(w), c = bf_hi(w); mx = fmaxf(mx, wave_sum(a * a + c * c, lane)); }
        if (lane == 0) red[512 + wave] = mx;
        __syncthreads();
        if (tid < 128) KMEAN[((size_t)(b * 8 + h) * 16 + j) * 128 + tid] = (red[tid] + red[128 + tid] + red[256 + tid] + red[384 + tid]) * (1.f / 256.f);
        if (tid == 0) { float m8 = red[512]; for (int w = 1; w < 8; ++w) m8 = fmaxf(m8, red[512 + w]); KN[(b * 8 + h) * 16 + j] = __float_as_uint(m8); }
        __syncthreads();
    }
}
#define DOT8(W_, QA_, QB_) (bf_lo((W_).x) * (QA_).x + bf_hi((W_).x) * (QA_).y + bf_lo((W_).y) * (QA_).z + bf_hi((W_).y) * (QA_).w + bf_lo((W_).z) * (QB_).x + bf_hi((W_).z) * (QB_).y + bf_lo((W_).w) * (QB_).z + bf_hi((W_).w) * (QB_).w)
__device__ __forceinline__ void attn_valu_phase(const bf16* QK, const bf16* VT, const float* KMEAN, const float* rel_bias, bf16* O, LAS unsigned char* lds, int gw, int NGW, int wave, int lane) {
    LAS float* qs = (LAS float*)(lds + wave * 8192);
    LAS float* ps = qs + 128;
    const float scale = 0.08838834764831845f, NINF = -__builtin_inff();
    for (int idx = gw; idx < NB * 8 * SEQ; idx += NGW) {
        const int s = idx & 4095, bh = idx >> 12, h = bh & 7, b = bh >> 3, qb = s >> 8; const size_t row = (size_t)b * 4096 + s;
        const unsigned qq = *(const unsigned*)(QK + row * 2048 + h * 128 + 2 * lane);
        const float q0 = bf_lo(qq), q1 = bf_hi(qq);
        qs[2 * lane] = q0; qs[2 * lane + 1] = q1;
        float t0 = NINF, t1 = NINF, t2 = NINF; int i0 = 0, i1 = 1, i2 = 2;
        const float* km = KMEAN + (size_t)(b * 8 + h) * 16 * 128;
        for (int j = 0; j < qb; ++j) { const float g = wave_sum(q0 * km[j * 128 + 2 * lane] + q1 * km[j * 128 + 2 * lane + 1], lane);
            if (g > t0) { t2 = t1; i2 = i1; t1 = t0; i1 = i0; t0 = g; i0 = j; } else if (g > t1) { t2 = t1; i2 = i1; t1 = g; i1 = j; } else if (g > t2) { t2 = g; i2 = j; } }
        const int nsel = qb < 3 ? qb : 3;
        LDS_WAIT(); asm volatile("" ::: "memory");
        float mx = NINF;
        for (int blk = 0; blk <= nsel; ++blk) {
            const int kb = blk == 0 ? qb : (blk == 1 ? i0 : (blk == 2 ? i1 : i2));
            for (int kk = 0; kk < 4; ++kk) {
                const int key = kb * 256 + kk * 64 + lane;
                const bf16* kr = QK + ((size_t)b * 4096 + key) * 2048 + 1024 + h * 128;
                float dot = 0.f;
#pragma unroll 4
                for (int c = 0; c < 16; ++c) { const v4u w = *(const v4u*)(kr + 8 * c); const f32x4 qa = *(const LAS f32x4*)(qs + 8 * c), qc = *(const LAS f32x4*)(qs + 8 * c + 4); dot += DOT8(w, qa, qc); }
                const int dist = s - key;
                float sc = NINF;
                if (dist >= 0) { const int bucket = dist < 128 ? (int)T5_BUCKET[dist] : 31; sc = dot * scale + rel_bias[bucket * 8 + h]; }
                ps[blk * 256 + kk * 64 + lane] = sc; mx = fmaxf(mx, sc);
            }
        }
        mx = wave_max(mx, lane);
        LDS_WAIT(); asm volatile("" ::: "memory");
        float l = 0.f;
        const int nk = (nsel + 1) * 256;
        for (int i = lane; i < nk; i += 64) { const float p = __expf(ps[i] - mx); ps[i] = p; l += p; }
        l = wave_sum(l, lane);
        LDS_WAIT(); asm volatile("" ::: "memory");
        float o0 = 0.f, o1 = 0.f;
        for (int blk = 0; blk <= nsel; ++blk) {
            const int kb = blk == 0 ? qb : (blk == 1 ? i0 : (blk == 2 ? i1 : i2));
            const bf16* v0p = VT + (size_t)(h * 128 + 2 * lane) * M + (size_t)b * 4096 + kb * 256; const bf16* v1p = v0p + M;
#pragma unroll 4
            for (int k8 = 0; k8 < 32; ++k8) { const v4u a = *(const v4u*)(v0p + 8 * k8), c = *(const v4u*)(v1p + 8 * k8);
                const f32x4 pa = *(const LAS f32x4*)(ps + blk * 256 + 8 * k8), pb = *(const LAS f32x4*)(ps + blk * 256 + 8 * k8 + 4);
                o0 += DOT8(a, pa, pb); o1 += DOT8(c, pa, pb); }
        }
        const float inv = 1.f / l;
        *(unsigned*)(O + row * 1024 + h * 128 + 2 * lane) = pk2(o0 * inv, o1 * inv);
        LDS_WAIT(); asm volatile("" ::: "memory");
    }
}
__device__ __forceinline__ void pool_phase(const bf16* U, bf16* P, int gt, int NT) {
    for (int o = gt; o < M * 128; o += NT) {
        const int row = o >> 7, c8 = (o & 127) * 8, s = row & 4095, g = c8 >> 8, w = 2 << g;
        const int cnt = (s + 1 < w) ? s + 1 : w;
        float a0 = 0, a1 = 0, a2 = 0, a3 = 0, a4 = 0, a5 = 0, a6 = 0, a7 = 0;
        const v4u cur = *(const v4u*)(U + (size_t)row * 1024 + c8);
        for (int i = 0; i < cnt; ++i) { const v4u v = *(const v4u*)(U + (size_t)(row - i) * 1024 + c8);
            a0 += bf_lo(v.x); a1 += bf_hi(v.x); a2 += bf_lo(v.y); a3 += bf_hi(v.y); a4 += bf_lo(v.z); a5 += bf_hi(v.z); a6 += bf_lo(v.w); a7 += bf_hi(v.w); }
        const float ic = 1.f / (float)cnt;
        v4u r; r.x = pk2(a0 * ic - bf_lo(cur.x), a1 * ic - bf_hi(cur.x)); r.y = pk2(a2 * ic - bf_lo(cur.y), a3 * ic - bf_hi(cur.y));
        r.z = pk2(a4 * ic - bf_lo(cur.z), a5 * ic - bf_hi(cur.z)); r.w = pk2(a6 * ic - bf_lo(cur.w), a7 * ic - bf_hi(cur.w));
        *(v4u*)(P + (size_t)row * 1024 + c8) = r;
    }
}
__device__ __forceinline__ void gates_phase(const float* X, const float* c_w_in, const float* c_b_gates, float* GATES, int gw, int NGW, int lane) {
    for (int m = gw; m < M; m += NGW) {
        f32x4 a0 = {0.f, 0.f, 0.f, 0.f}, a1 = {0.f, 0.f, 0.f, 0.f};
#pragma unroll
        for (int j = 0; j < 4; ++j) { const f32x4 xv = ((const f32x4*)(X + (size_t)m * D))[lane + 64 * j]; const int k = (lane + 64 * j) * 4;
#pragma unroll
            for (int e = 0; e < 4; ++e) { const float* wr = c_w_in + (size_t)(k + e) * 4104 + 4096; const f32x4 w0 = *(const f32x4*)wr, w1 = *(const f32x4*)(wr + 4); a0 += w0 * xv[e]; a1 += w1 * xv[e]; } }
        float r0 = wave_sum(a0.x, lane), r1 = wave_sum(a0.y, lane), r2 = wave_sum(a0.z, lane), r3 = wave_sum(a0.w, lane), r4 = wave_sum(a1.x, lane), r5 = wave_sum(a1.y, lane), r6 = wave_sum(a1.z, lane), r7 = wave_sum(a1.w, lane);
        if (lane < 8) { const float v = lane == 0 ? r0 : lane == 1 ? r1 : lane == 2 ? r2 : lane == 3 ? r3 : lane == 4 ? r4 : lane == 5 ? r5 : lane == 6 ? r6 : r7; GATES[(size_t)m * 8 + lane] = v + c_b_gates[lane]; }
    }
}
__device__ __forceinline__ void conv_phase(const bf16* PROJ, const float* conv_w, bf16* QC, bf16* KC, int gt, int NT) {
    for (int o = gt; o < M * 256; o += NT) {
        const int row = o >> 8, c8 = (o & 255) * 8, s = row & 4095;
        f32x4 lo = {0.f, 0.f, 0.f, 0.f}, hi = {0.f, 0.f, 0.f, 0.f};
#pragma unroll
        for (int j = 0; j < 4; ++j) { if (s - 3 + j >= 0) { const v4u v = *(const v4u*)(PROJ + (size_t)(row - 3 + j) * 4096 + c8);
                const f32x4 w0 = *(const f32x4*)(conv_w + j * 2048 + c8), w1 = *(const f32x4*)(conv_w + j * 2048 + c8 + 4);
                lo += w0 * (f32x4){bf_lo(v.x), bf_hi(v.x), bf_lo(v.y), bf_hi(v.y)}; hi += w1 * (f32x4){bf_lo(v.z), bf_hi(v.z), bf_lo(v.w), bf_hi(v.w)}; } }
        const float sc = c8 >= 1024 ? 0.0625f : 1.0f;
        v4u r; r.x = pk2(pg8::silu_f(lo.x) * sc, pg8::silu_f(lo.y) * sc); r.y = pk2(pg8::silu_f(lo.z) * sc, pg8::silu_f(lo.w) * sc);
        r.z = pk2(pg8::silu_f(hi.x) * sc, pg8::silu_f(hi.y) * sc); r.w = pk2(pg8::silu_f(hi.z) * sc, pg8::silu_f(hi.w) * sc);
        if (c8 >= 1024) *(v4u*)(KC + (size_t)row * 1024 + (c8 - 1024)) = r; else *(v4u*)(QC + (size_t)row * 1024 + c8) = r;
    }
}
__device__ __forceinline__ void mlstm_valu_phase(const bf16* QC, const bf16* KC, const bf16* PROJ, const float* GATES, float* HT, LAS unsigned char* lds, int tid, int G) {
    LAS float* Cst = (LAS float*)lds;
    LAS float* nst = Cst + 256 * 33;
    LAS bf16* qs = (LAS bf16*)(nst + 256);
    LAS bf16* ks = qs + 64 * 264;
    LAS float* vsm = (LAS float*)(ks + 64 * 264);
    LAS float* Wm = vsm + 64 * 33;
    LAS float* sv = Wm + 64 * 65;
    for (int u = blockIdx.x; u < 128; u += G) {
        const int vsl = u & 7, h = (u >> 3) & 3, b = u >> 5;
        for (int i = tid; i < 256 * 33; i += 512) Cst[i] = 0.f;
        if (tid < 256) nst[tid] = 0.f;
        if (tid == 0) sv[320] = 0.f;
        __syncthreads();
        for (int c = 0; c < 64; ++c) {
            const size_t row0 = (size_t)b * 4096 + c * 64;
            for (int i = tid; i < 2048; i += 512) { const int r = i >> 5, c8 = (i & 31) * 8;
                *(LAS v4u*)(qs + r * 264 + c8) = *(const v4u*)(QC + (row0 + r) * 1024 + h * 256 + c8);
                *(LAS v4u*)(ks + r * 264 + c8) = *(const v4u*)(KC + (row0 + r) * 1024 + h * 256 + c8); }
            { const int r = tid >> 3, c4 = (tid & 7) * 4; const v2u w = *(const v2u*)(PROJ + (row0 + r) * 4096 + 2048 + h * 256 + vsl * 32 + c4);
              vsm[r * 33 + c4] = bf_lo(w.x); vsm[r * 33 + c4 + 1] = bf_hi(w.x); vsm[r * 33 + c4 + 2] = bf_lo(w.y); vsm[r * 33 + c4 + 3] = bf_hi(w.y); }
            if (tid < 64) {
                const float ig = GATES[(row0 + tid) * 8 + h], fp = GATES[(row0 + tid) * 8 + 4 + h];
                const float lf = fminf(fp, 0.f) - log1pf(__expf(-fabsf(fp)));
                float bsum = lf;
#pragma unroll
                for (int o = 1; o < 64; o <<= 1) { const float t = shidx(bsum, tid - o); if (tid >= o) bsum += t; }
                const float av = ig - bsum;
                float cm = av;
#pragma unroll
                for (int o = 1; o < 64; o <<= 1) { const float t = shidx(cm, tid - o); if (tid >= o) cm = fmaxf(cm, t); }
                const float mp = sv[320];
                const float m_inter = bsum + mp, mt = fmaxf(m_inter, bsum + cm);
                const float blast = shidx(bsum, 63);
                const float gs = blast - bsum + ig;
                const float mnew = fmaxf(blast + mp, wave_max(gs, tid));
                sv[tid] = bsum; sv[64 + tid] = av; sv[128 + tid] = mt; sv[192 + tid] = __expf(m_inter - mt); sv[256 + tid] = __expf(gs - mnew);
                if (tid == 0) { sv[321] = __expf(blast + mp - mnew); sv[322] = mnew; }
            }
            __syncthreads();
            { const int t = tid >> 3, sg = tid & 7; const float bt = sv[t], mt = sv[128 + t];
              float d0 = 0, d1 = 0, d2 = 0, d3 = 0, d4 = 0, d5 = 0, d6 = 0, d7 = 0;
              if (sg * 8 <= t) {
                  for (int dk8 = 0; dk8 < 32; ++dk8) { const v4u qv = *(const LAS v4u*)(qs + t * 264 + dk8 * 8);
                      const f32x4 qa = {bf_lo(qv.x), bf_hi(qv.x), bf_lo(qv.y), bf_hi(qv.y)}, qc = {bf_lo(qv.z), bf_hi(qv.z), bf_lo(qv.w), bf_hi(qv.w)};
                      const LAS bf16* kp = ks + (sg * 8) * 264 + dk8 * 8;
                      { const v4u w = *(const LAS v4u*)(kp + 0 * 264); d0 += DOT8(w, qa, qc); } { const v4u w = *(const LAS v4u*)(kp + 1 * 264); d1 += DOT8(w, qa, qc); }
                      { const v4u w = *(const LAS v4u*)(kp + 2 * 264); d2 += DOT8(w, qa, qc); } { const v4u w = *(const LAS v4u*)(kp + 3 * 264); d3 += DOT8(w, qa, qc); }
                      { const v4u w = *(const LAS v4u*)(kp + 4 * 264); d4 += DOT8(w, qa, qc); } { const v4u w = *(const LAS v4u*)(kp + 5 * 264); d5 += DOT8(w, qa, qc); }
                      { const v4u w = *(const LAS v4u*)(kp + 6 * 264); d6 += DOT8(w, qa, qc); } { const v4u w = *(const LAS v4u*)(kp + 7 * 264); d7 += DOT8(w, qa, qc); } }
              }
#define WSTORE(e, dv) { const int s_ = sg * 8 + e; Wm[t * 65 + s_] = (s_ <= t) ? __expf(bt + sv[64 + s_] - mt) * dv : 0.f; }
              WSTORE(0, d0) WSTORE(1, d1) WSTORE(2, d2) WSTORE(3, d3) WSTORE(4, d4) WSTORE(5, d5) WSTORE(6, d6) WSTORE(7, d7)
#undef WSTORE
            }
            __syncthreads();
            { const int t = tid >> 3, vg = tid & 7; const float sint = sv[192 + t], mt = sv[128 + t];
              f32x4 inter = {0.f, 0.f, 0.f, 0.f}, intra = {0.f, 0.f, 0.f, 0.f}; float qn = 0.f, wsum = 0.f;
              for (int dk = 0; dk < 256; ++dk) { const float qv = bf1(qs[t * 264 + dk]); qn += qv * nst[dk]; const LAS float* cp = Cst + dk * 33 + vg * 4; inter += (f32x4){cp[0], cp[1], cp[2], cp[3]} * qv; }
              for (int s = 0; s <= t; ++s) { const float w = Wm[t * 65 + s]; wsum += w; const LAS float* vp = vsm + s * 33 + vg * 4; intra += (f32x4){vp[0], vp[1], vp[2], vp[3]} * w; }
              const float den = sint * qn + wsum; const float dd = 1.f / fmaxf(fabsf(den), __expf(-mt));
              *(f32x4*)(HT + (row0 + t) * 1024 + h * 256 + vsl * 32 + vg * 4) = (inter * sint + intra) * dd; }
            __syncthreads();
            { const int dk = tid >> 1, hf = tid & 1; const float decay = sv[321];
              f32x4 c0 = {0.f, 0.f, 0.f, 0.f}, c1 = c0, c2 = c0, c3 = c0; float nacc = 0.f;
              for (int s = 0; s < 64; ++s) { const float kw = bf1(ks[s * 264 + dk]) * sv[256 + s]; nacc += kw; const LAS float* vp = vsm + s * 33 + hf * 16;
                  c0 += (f32x4){vp[0], vp[1], vp[2], vp[3]} * kw; c1 += (f32x4){vp[4], vp[5], vp[6], vp[7]} * kw; c2 += (f32x4){vp[8], vp[9], vp[10], vp[11]} * kw; c3 += (f32x4){vp[12], vp[13], vp[14], vp[15]} * kw; }
              LAS float* cp = Cst + dk * 33 + hf * 16;
#pragma unroll
              for (int e = 0; e < 4; ++e) { cp[e] = decay * cp[e] + c0[e]; cp[4 + e] = decay * cp[4 + e] + c1[e]; cp[8 + e] = decay * cp[8 + e] + c2[e]; cp[12 + e] = decay * cp[12 + e] + c3[e]; }
              if (hf == 0) nst[dk] = decay * nst[dk] + nacc;
              if (tid == 0) sv[320] = sv[322]; }
            __syncthreads();
        }
    }
}
__device__ __forceinline__ void headnorm_phase(const float* HT, const bf16* PROJ, const float* norm_g, bf16* HN, int gw, int NGW, int lane) {
    for (int m = gw; m < M; m += NGW) {
#pragma unroll
        for (int hh = 0; hh < 4; ++hh) { const int idx = hh * 256 + lane * 4;
            const f32x4 ht = *(const f32x4*)(HT + (size_t)m * 1024 + idx); const v2u ow = *(const v2u*)(PROJ + (size_t)m * 4096 + 3072 + idx);
            const f32x4 op = {bf_lo(ow.x), bf_hi(ow.x), bf_lo(ow.y), bf_hi(ow.y)};
            f32x4 hc;
#pragma unroll
            for (int e = 0; e < 4; ++e) hc[e] = ht[e] / (1.f + __expf(-op[e]));
            const float mu = wave_sum((hc.x + hc.y) + (hc.z + hc.w), lane) * (1.f / 256.f);
            hc = hc - mu;
            const float var = wave_sum((hc.x * hc.x + hc.y * hc.y) + (hc.z * hc.z + hc.w * hc.w), lane) * (1.f / 256.f);
            const float rstd = 1.f / sqrtf(var + LN_EPS);
            const f32x4 ng = *(const f32x4*)(norm_g + idx);
            const f32x4 o = hc * rstd * ng;
            v2u w; w.x = pk2(o.x, o.y); w.y = pk2(o.z, o.w);
            *(v2u*)(HN + (size_t)m * 1024 + idx) = w; }
    }
}
typedef short bf16x8v __attribute__((ext_vector_type(8)));
typedef float f32x16 __attribute__((ext_vector_type(16)));
typedef float f32x2_t __attribute__((ext_vector_type(2)));
typedef __bf16 bf16x2_t __attribute__((ext_vector_type(2)));
__device__ __forceinline__ unsigned cvtpk(float lo, float hi) { f32x2_t v = {lo, hi}; bf16x2_t b = __builtin_convertvector(v, bf16x2_t); return __builtin_bit_cast(unsigned, b); }
constexpr int AT_KROW = 272, AT_VROW = 528, AT_KS = 0, AT_VS = 256 * AT_KROW, AT_KML = AT_VS + 128 * AT_VROW, AT_BL = AT_KML + 8192;
static_assert(AT_BL + 512 <= LDS_BYTES, "attention LDS map");
template <int MODE  >
__device__ __forceinline__ void attn_block(LAS unsigned char* lds, const bf16x8v (&qf)[8], f32x16 (&oacc)[4], float& lsum, int ql, int hi, int qi, float c1, float cfar, float negm, float rs) {
    const LAS unsigned char* Ks = lds + AT_KS; const LAS unsigned char* Vs = lds + AT_VS; const LAS float* bl = (const LAS float*)(lds + AT_BL);
#pragma unroll 1
    for (int kt = 0; kt < 8; ++kt) {
        f32x16 sacc;
#pragma unroll
        for (int i = 0; i < 16; ++i) sacc[i] = 0.f;
#pragma unroll
        for (int dd = 0; dd < 8; ++dd) { const bf16x8v kf = *(const LAS bf16x8v*)(Ks + (kt * 32 + ql) * AT_KROW + dd * 32 + hi * 16); sacc = __builtin_amdgcn_mfma_f32_32x32x16_bf16(kf, qf[dd], sacc, 0, 0, 0); }
        float p[16];
#pragma unroll
        for (int i = 0; i < 16; ++i) {
            const int key = kt * 32 + (i & 3) + 8 * (i >> 2) + 4 * hi;
            float x;
            if (MODE == 0) x = sacc[i] * c1 + cfar;
            else { int dist = (MODE == 1 ? 256 : 0) + qi - key; int idx = dist < 0 ? 0 : (dist > 127 ? 127 : dist); x = sacc[i] * c1 + (bl[idx] + negm); }
            float e = __builtin_amdgcn_exp2f(x) * rs;
            if (MODE == 2) e = (key <= qi) ? e : 0.f;
            p[i] = e; lsum += e;
        }
        v4u pw0, pw1;
        pw0.x = cvtpk(p[0], p[1]); pw0.y = cvtpk(p[2], p[3]); pw0.z = cvtpk(p[4], p[5]); pw0.w = cvtpk(p[6], p[7]);
        pw1.x = cvtpk(p[8], p[9]); pw1.y = cvtpk(p[10], p[11]); pw1.z = cvtpk(p[12], p[13]); pw1.w = cvtpk(p[14], p[15]);
        const bf16x8v pf0 = __builtin_bit_cast(bf16x8v, pw0), pf1 = __builtin_bit_cast(bf16x8v, pw1);
#pragma unroll
        for (int dt = 0; dt < 4; ++dt) {
            const bf16x8v v0 = *(const LAS bf16x8v*)(Vs + (dt * 32 + ql) * AT_VROW + kt * 64 + hi * 16);
            const bf16x8v v1 = *(const LAS bf16x8v*)(Vs + (dt * 32 + ql) * AT_VROW + kt * 64 + 32 + hi * 16);
            oacc[dt] = __builtin_amdgcn_mfma_f32_32x32x16_bf16(v0, pf0, oacc[dt], 0, 0, 0);
            oacc[dt] = __builtin_amdgcn_mfma_f32_32x32x16_bf16(v1, pf1, oacc[dt], 0, 0, 0);
        }
    }
}
__device__ __forceinline__ void attn_mfma_phase(const bf16* QK, const bf16* VT, const float* KMEAN, const unsigned* KN, const float* rel_bias, bf16* O, LAS unsigned char* lds, int tid, int G) {
    constexpr float LOG2E = 1.4426950408889634f, SCALE = 0.08838834764831845f;
    LAS float* kml = (LAS float*)(lds + AT_KML); LAS float* bl = (LAS float*)(lds + AT_BL);
#pragma unroll 1
    for (int u = blockIdx.x; u < 256; u += G) {
        asm volatile("" : "+v"(tid));
        const int lane = tid & 63, wave = tid >> 6, ql = lane & 31, hi = lane >> 5;
        const int bh = u >> 3, pp = u & 7, b = bh >> 3, h = bh & 7;
        __syncthreads();
        for (int i = tid; i < 2048; i += 512) kml[i] = KMEAN[(size_t)bh * 2048 + i];
        if (tid < 128) bl[tid] = rel_bias[(int)T5_BUCKET[tid] * 8 + h] * LOG2E;
        float bmax = rel_bias[h];
        for (int k = 1; k < 32; ++k) bmax = fmaxf(bmax, rel_bias[k * 8 + h]);
        float kn2 = __uint_as_float(KN[bh * 16]);
        for (int k = 1; k < 16; ++k) kn2 = fmaxf(kn2, __uint_as_float(KN[bh * 16 + k]));
        const float knmax = sqrtf(kn2);
        const float cfar_b = rel_bias[31 * 8 + h] * LOG2E;
        __syncthreads();
#pragma unroll 1
        for (int half = 0; half < 2; ++half) {
            asm volatile("" : "+v"(tid));
            const int lane = tid & 63, wave = tid >> 6, ql = lane & 31, hi = lane >> 5;
            const int qb = half == 0 ? pp : 15 - pp;
            const int qi = wave * 32 + ql;
            const size_t qrow = (size_t)b * 4096 + qb * 256 + qi;
            bf16x8v qf[8];
#pragma unroll
            for (int dd = 0; dd < 8; ++dd) qf[dd] = *(const bf16x8v*)(QK + qrow * 2048 + h * 128 + dd * 16 + hi * 8);
            float qn2 = 0.f; float gate[16];
#pragma unroll
            for (int j = 0; j < 16; ++j) gate[j] = 0.f;
#pragma unroll
            for (int dd = 0; dd < 8; ++dd) {
                float qv[8];
#pragma unroll
                for (int e = 0; e < 8; ++e) { qv[e] = __builtin_bit_cast(float, (unsigned)(unsigned short)qf[dd][e] << 16); qn2 += qv[e] * qv[e]; }
#pragma unroll
                for (int j = 0; j < 15; ++j) if (j < qb) { const LAS float* kp = kml + j * 128 + dd * 16 + hi * 8; const f32x4 k0 = *(const LAS f32x4*)kp, k1 = *(const LAS f32x4*)(kp + 4);
                    gate[j] += qv[0] * k0.x + qv[1] * k0.y + qv[2] * k0.z + qv[3] * k0.w + qv[4] * k1.x + qv[5] * k1.y + qv[6] * k1.z + qv[7] * k1.w; }
            }
            qn2 += shx(qn2, 32, lane);
            unsigned sel = 1u << qb;
            if (qb <= 3) sel |= (1u << qb) - 1u;
            else {
#pragma unroll
                for (int j = 0; j < 15; ++j) gate[j] += shx(gate[j], 32, lane);
#pragma unroll
                for (int r = 0; r < 3; ++r) { float best = -__builtin_inff(); int bi = 0;
#pragma unroll
                    for (int j = 0; j < 15; ++j) { const bool ok = (j < qb) && !((sel >> j) & 1u) && (gate[j] > best); best = ok ? gate[j] : best; bi = ok ? j : bi; }
                    sel |= 1u << bi; }
            }
            const float negm = -LOG2E * (SCALE * sqrtf(qn2) * knmax + bmax);
            const float c1 = SCALE * LOG2E, cfar = cfar_b + negm;
            f32x16 oacc[4];
#pragma unroll
            for (int dt = 0; dt < 4; ++dt)
#pragma unroll
                for (int i = 0; i < 16; ++i) oacc[dt][i] = 0.f;
            float lsum = 0.f;
#pragma unroll 1
            for (int j = 0; j <= qb; ++j) {
                __syncthreads();
                { int tl = tid; asm volatile("" : "+v"(tl));
                  const bf16* kg = QK + ((size_t)b * 4096 + j * 256) * 2048 + 1024 + h * 128;
#pragma unroll
                  for (int i = 0; i < 8; ++i) { const int c = tl + i * 512, r = c >> 4, cc = c & 15; const v4u v = *(const v4u*)(kg + (size_t)r * 2048 + cc * 8); *(LAS v4u*)(lds + AT_KS + r * AT_KROW + cc * 16) = v; }
                  const bf16* vg = VT + (size_t)(h * 128) * M + (size_t)b * 4096 + j * 256;
#pragma unroll
                  for (int i = 0; i < 8; ++i) { const int c = tl + i * 512, r = c >> 5, cc = c & 31, odd = cc & 1; const v4u v = *(const v4u*)(vg + (size_t)r * M + cc * 8);
                      LAS unsigned char* dst = lds + AT_VS + r * AT_VROW + (cc >> 1) * 32; v2u lo2, hi2; lo2.x = v.x; lo2.y = v.y; hi2.x = v.z; hi2.y = v.w;
                      *(LAS v2u*)(dst + (odd ? 8 : 0)) = lo2; *(LAS v2u*)(dst + (odd ? 24 : 16)) = hi2; } }
                __syncthreads();
                const float rs = ((sel >> j) & 1u) ? 1.f : 0.f;
                if (j == qb) attn_block<2>(lds, qf, oacc, lsum, ql, hi, qi, c1, cfar, negm, rs);
                else if (j == qb - 1) attn_block<1>(lds, qf, oacc, lsum, ql, hi, qi, c1, cfar, negm, rs);
                else attn_block<0>(lds, qf, oacc, lsum, ql, hi, qi, c1, cfar, negm, rs);
            }
            lsum += shx(lsum, 32, lane);
            const float inv = 1.f / lsum;
            bf16* orow = O + qrow * 1024 + h * 128;
#pragma unroll
            for (int dt = 0; dt < 4; ++dt)
#pragma unroll
                for (int g4 = 0; g4 < 4; ++g4) { v2u w; w.x = cvtpk(oacc[dt][4 * g4] * inv, oacc[dt][4 * g4 + 1] * inv); w.y = cvtpk(oacc[dt][4 * g4 + 2] * inv, oacc[dt][4 * g4 + 3] * inv);
                    *(v2u*)(orow + dt * 32 + 8 * g4 + 4 * hi) = w; }
        }
    }
}
typedef float f32x4m __attribute__((ext_vector_type(4)));
constexpr int ML_QS = 0, ML_KS = 33792, ML_KT = 67584, ML_VT = 104448, ML_VTS = 106752, ML_WB = 109056, ML_CT = 118272, ML_NST = 126720, ML_SV = 127744;
static_assert(ML_SV + 4096 <= LDS_BYTES, "mLSTM LDS map");
#define MFMA16(a, b, c) __builtin_amdgcn_mfma_f32_16x16x32_bf16((a), (b), (c), 0, 0, 0)
__device__ __forceinline__ void conv2_phase(const bf16* QKP, const bf16* KVT, const float* conv_w, bf16* QC, bf16* KC, bf16* KT, int gt, int NT) {
    for (int o = gt; o < M * 256; o += NT) {
        const int row = o >> 8, c8 = (o & 255) * 8, s = row & 4095;
        f32x4 lo = {0.f, 0.f, 0.f, 0.f}, hi = {0.f, 0.f, 0.f, 0.f};
#pragma unroll
        for (int j = 0; j < 4; ++j) { if (s - 3 + j >= 0) { const v4u v = *(const v4u*)(QKP + (size_t)(row - 3 + j) * 2048 + c8);
                const f32x4 w0 = *(const f32x4*)(conv_w + j * 2048 + c8), w1 = *(const f32x4*)(conv_w + j * 2048 + c8 + 4);
                lo += w0 * (f32x4){bf_lo(v.x), bf_hi(v.x), bf_lo(v.y), bf_hi(v.y)}; hi += w1 * (f32x4){bf_lo(v.z), bf_hi(v.z), bf_lo(v.w), bf_hi(v.w)}; } }
        const float sc = c8 >= 1024 ? 0.0625f : 1.0f;
        v4u r; r.x = pk2(pg8::silu_f(lo.x) * sc, pg8::silu_f(lo.y) * sc); r.y = pk2(pg8::silu_f(lo.z) * sc, pg8::silu_f(lo.w) * sc);
        r.z = pk2(pg8::silu_f(hi.x) * sc, pg8::silu_f(hi.y) * sc); r.w = pk2(pg8::silu_f(hi.z) * sc, pg8::silu_f(hi.w) * sc);
        if (c8 >= 1024) *(v4u*)(KC + (size_t)row * 1024 + (c8 - 1024)) = r; else *(v4u*)(QC + (size_t)row * 1024 + c8) = r;
    }
    for (int o = gt; o < 1024 * (M / 8); o += NT) {
        const int ch = o >> 11, m8 = (o & 2047) * 8, s = m8 & 4095;
        const bf16* src = KVT + (size_t)ch * M + m8;
        const v4u cur = *(const v4u*)src; v4u prv = {0u, 0u, 0u, 0u};
        if (s != 0) prv = *(const v4u*)(src - 8);
        float x[11];
        x[0] = bf_hi(prv.z); x[1] = bf_lo(prv.w); x[2] = bf_hi(prv.w);
        x[3] = bf_lo(cur.x); x[4] = bf_hi(cur.x); x[5] = bf_lo(cur.y); x[6] = bf_hi(cur.y); x[7] = bf_lo(cur.z); x[8] = bf_hi(cur.z); x[9] = bf_lo(cur.w); x[10] = bf_hi(cur.w);
        const float w0 = conv_w[1024 + ch], w1 = conv_w[2048 + 1024 + ch], w2 = conv_w[4096 + 1024 + ch], w3 = conv_w[6144 + 1024 + ch];
        float y[8];
#pragma unroll
        for (int e = 0; e < 8; ++e) y[e] = pg8::silu_f(w0 * x[e] + w1 * x[e + 1] + w2 * x[e + 2] + w3 * x[e + 3]) * 0.0625f;
        v4u r; r.x = pk2(y[0], y[1]); r.y = pk2(y[2], y[3]); r.z = pk2(y[4], y[5]); r.w = pk2(y[6], y[7]);
        *(v4u*)(KT + (size_t)ch * M + m8) = r;
    }
}
__device__ __forceinline__ void mlstm_mfma_phase(const bf16* QC, const bf16* KC, const bf16* KT, const bf16* KVT, const float* GATES, float* HT, LAS unsigned char* lds, int tid_in, int G) {
#pragma unroll 1
    for (int u = blockIdx.x; u < 256; u += G) {
        int tid = tid_in; asm volatile("" : "+v"(tid));
        const int lane = tid & 63, wave = __builtin_amdgcn_readfirstlane(tid >> 6), fr = lane & 15, fq = lane >> 4;
        const int vsl = u & 15, h = (u >> 4) & 3, b = u >> 6;
        LAS float* sv = (LAS float*)(lds + ML_SV); LAS float* nst = (LAS float*)(lds + ML_NST);
        __syncthreads();
        for (int i = tid; i < 16 * 264 / 2; i += 512) ((LAS unsigned*)(lds + ML_CT))[i] = 0u;
        if (tid < 256) nst[tid] = 0.f;
        if (tid == 0) sv[640] = 0.f;
        f32x4m accC[2] = {{0.f, 0.f, 0.f, 0.f}, {0.f, 0.f, 0.f, 0.f}};
        v4u pq[4], pk[4], pt[4], pv = {0u, 0u, 0u, 0u}; float pgi = 0.f, pgf = 0.f;
        const size_t rowb = (size_t)b * 4096;
#define ML_PREFETCH(c_) do { const size_t row0_ = rowb + (size_t)(c_) * 64; \
            _Pragma("unroll") for (int e = 0; e < 4; ++e) { const int i = tid + 512 * e; const int r = i >> 5, c8 = (i & 31) * 8; \
                pq[e] = *(const v4u*)(QC + (row0_ + r) * 1024 + h * 256 + c8); pk[e] = *(const v4u*)(KC + (row0_ + r) * 1024 + h * 256 + c8); \
                const int dk = i >> 3, s8 = (i & 7) * 8; pt[e] = *(const v4u*)(KT + (size_t)(h * 256 + dk) * M + row0_ + s8); } \
            if (tid < 128) pv = *(const v4u*)(KVT + (size_t)(1024 + h * 256 + vsl * 16 + (tid >> 3)) * M + row0_ + (tid & 7) * 8); \
            if (tid < 64) { pgi = GATES[(row0_ + tid) * 8 + h]; pgf = GATES[(row0_ + tid) * 8 + 4 + h]; } } while (0)
        ML_PREFETCH(0);
#pragma unroll 1
        for (int c = 0; c < 64; ++c) {
            const size_t row0 = rowb + (size_t)c * 64;
#pragma unroll
            for (int e = 0; e < 4; ++e) { const int i = tid + 512 * e; const int r = i >> 5, c8 = (i & 31) * 8;
                *(LAS v4u*)(lds + ML_QS + r * 528 + c8 * 2) = pq[e]; *(LAS v4u*)(lds + ML_KS + r * 528 + c8 * 2) = pk[e];
                const int dk = i >> 3, s8 = (i & 7) * 8; *(LAS v4u*)(lds + ML_KT + dk * 144 + s8 * 2) = pt[e]; }
            if (tid < 128) *(LAS v4u*)(lds + ML_VT + (tid >> 3) * 144 + (tid & 7) * 16) = pv;
            if (tid < 64) {
                const float ig = pgi, fp = pgf;
                const float lf = fminf(fp, 0.f) - log1pf(__expf(-fabsf(fp)));
                float bsum = lf;
#pragma unroll
                for (int o = 1; o < 64; o <<= 1) { const float t = shidx(bsum, tid - o); if (tid >= o) bsum += t; }
                const float av = ig - bsum;
                float cm = av;
#pragma unroll
                for (int o = 1; o < 64; o <<= 1) { const float t = shidx(cm, tid - o); if (tid >= o) cm = fmaxf(cm, t); }
                const float mp = sv[640];
                const float m_inter = bsum + mp, mt = fmaxf(m_inter, bsum + cm);
                const float blast = shidx(bsum, 63);
                const float gs = blast - bsum + ig;
                const float mnew = fmaxf(blast + mp, wave_max(gs, tid));
                sv[tid] = bsum; sv[64 + tid] = av; sv[128 + tid] = mt; sv[192 + tid] = __expf(m_inter - mt); sv[256 + tid] = __expf(gs - mnew);
                if (tid == 0) { sv[641] = __expf(blast + mp - mnew); sv[642] = mnew; }
            }
            if (c + 1 < 64) ML_PREFETCH(c + 1);
            __syncthreads();
            {
                const int tt = wave & 3, sh = wave >> 2; const int t = tt * 16 + fr; const float bt = sv[t], mt = sv[128 + t];
                float wpart = 0.f;
#pragma unroll
                for (int si = 0; si < 2; ++si) { const int st = 2 * sh + si;
                    f32x4m acc = {0.f, 0.f, 0.f, 0.f};
                    if (st <= tt) {
#pragma unroll
                        for (int kk = 0; kk < 8; ++kk) { const bf16x8v kf = *(const LAS bf16x8v*)(lds + ML_KS + (st * 16 + fr) * 528 + kk * 64 + fq * 16), qf = *(const LAS bf16x8v*)(lds + ML_QS + t * 528 + kk * 64 + fq * 16); acc = MFMA16(kf, qf, acc); }
                    }
                    float wv[4];
#pragma unroll
                    for (int jj = 0; jj < 4; ++jj) { const int s = st * 16 + 4 * fq + jj; wv[jj] = (s <= t) ? __expf(bt + sv[64 + s] - mt) * acc[jj] : 0.f; wpart += wv[jj]; }
                    v2u w2; w2.x = cvtpk(wv[0], wv[1]); w2.y = cvtpk(wv[2], wv[3]);
                    *(LAS v2u*)(lds + ML_WB + t * 144 + (st * 16 + 4 * fq) * 2) = w2;
                }
                wpart += shx(wpart, 16, lane); wpart += shx(wpart, 32, lane);
                if (fq == 0) sv[320 + sh * 64 + t] = wpart;
                if (tid < 128) { const int v = tid >> 3, s8 = (tid & 7) * 8; const v4u x = *(const LAS v4u*)(lds + ML_VT + v * 144 + s8 * 2); const LAS float* wk = sv + 256 + s8;
                    v4u r; r.x = cvtpk(bf_lo(x.x) * wk[0], bf_hi(x.x) * wk[1]); r.y = cvtpk(bf_lo(x.y) * wk[2], bf_hi(x.y) * wk[3]); r.z = cvtpk(bf_lo(x.z) * wk[4], bf_hi(x.z) * wk[5]); r.w = cvtpk(bf_lo(x.w) * wk[6], bf_hi(x.w) * wk[7]);
                    *(LAS v4u*)(lds + ML_VTS + v * 144 + s8 * 2) = r; }
            }
            __syncthreads();
            f32x4m inter = {0.f, 0.f, 0.f, 0.f}, intra = {0.f, 0.f, 0.f, 0.f};
            if (wave < 4) {
                const int tt = wave;
#pragma unroll
                for (int kk = 0; kk < 8; ++kk) { const bf16x8v qf = *(const LAS bf16x8v*)(lds + ML_QS + (tt * 16 + fr) * 528 + kk * 64 + fq * 16), cf = *(const LAS bf16x8v*)(lds + ML_CT + fr * 528 + kk * 64 + fq * 16); inter = MFMA16(qf, cf, inter); }
#pragma unroll
                for (int kk = 0; kk < 2; ++kk) { const bf16x8v wf = *(const LAS bf16x8v*)(lds + ML_WB + (tt * 16 + fr) * 144 + kk * 64 + fq * 16), vf = *(const LAS bf16x8v*)(lds + ML_VT + fr * 144 + kk * 64 + fq * 16); intra = MFMA16(wf, vf, intra); }
            } else {
                const int t = (wave - 4) * 16 + (lane >> 2), part = lane & 3; float a = 0.f;
#pragma unroll
                for (int e = 0; e < 8; ++e) { const v4u x = *(const LAS v4u*)(lds + ML_QS + t * 528 + (part * 64 + e * 8) * 2); const LAS float* np = nst + part * 64 + e * 8;
                    a += bf_lo(x.x) * np[0] + bf_hi(x.x) * np[1] + bf_lo(x.y) * np[2] + bf_hi(x.y) * np[3] + bf_lo(x.z) * np[4] + bf_hi(x.z) * np[5] + bf_lo(x.w) * np[6] + bf_hi(x.w) * np[7]; }
                a += shx(a, 1, lane); a += shx(a, 2, lane);
                if (part == 0) sv[448 + t] = a;
            }
            __syncthreads();
            if (wave < 4) {
#pragma unroll
                for (int jj = 0; jj < 4; ++jj) { const int t = wave * 16 + 4 * fq + jj; const float sint = sv[192 + t], mt = sv[128 + t];
                    const float den = sint * sv[448 + t] + sv[320 + t] + sv[384 + t]; const float dd = 1.f / fmaxf(fabsf(den), __expf(-mt));
                    HT[(row0 + t) * 1024 + h * 256 + vsl * 16 + fr] = (sint * inter[jj] + intra[jj]) * dd; }
            }
            {
                const float decay = sv[641];
#pragma unroll
                for (int i = 0; i < 2; ++i) { const int dkt = 2 * wave + i; f32x4m a = accC[i] * decay;
#pragma unroll
                    for (int kk = 0; kk < 2; ++kk) { const bf16x8v vf = *(const LAS bf16x8v*)(lds + ML_VTS + fr * 144 + kk * 64 + fq * 16), kf = *(const LAS bf16x8v*)(lds + ML_KT + (dkt * 16 + fr) * 144 + kk * 64 + fq * 16); a = MFMA16(vf, kf, a); }
                    accC[i] = a;
#pragma unroll
                    for (int jj = 0; jj < 4; ++jj) *(LAS bf16*)(lds + ML_CT + (4 * fq + jj) * 528 + (dkt * 16 + fr) * 2) = (bf16)(cvtpk(a[jj], 0.f) & 0xffffu);
                }
                if (tid < 256) { float a = 0.f;
#pragma unroll
                    for (int e = 0; e < 8; ++e) { const v4u x = *(const LAS v4u*)(lds + ML_KT + tid * 144 + e * 16); const LAS float* wk = sv + 256 + e * 8;
                        a += bf_lo(x.x) * wk[0] + bf_hi(x.x) * wk[1] + bf_lo(x.y) * wk[2] + bf_hi(x.y) * wk[3] + bf_lo(x.z) * wk[4] + bf_hi(x.z) * wk[5] + bf_lo(x.w) * wk[6] + bf_hi(x.w) * wk[7]; }
                    nst[tid] = decay * nst[tid] + a; }
                if (tid == 0) sv[640] = sv[642];
            }
            __syncthreads();
        }
#undef ML_PREFETCH
    }
}
__device__ __forceinline__ void headnorm2_phase(const float* HT, const bf16* OP, const float* norm_g, bf16* HN, int gw, int NGW, int lane) {
    for (int m = gw; m < M; m += NGW) {
#pragma unroll
        for (int hh = 0; hh < 4; ++hh) { const int idx = hh * 256 + lane * 4;
            const f32x4 ht = *(const f32x4*)(HT + (size_t)m * 1024 + idx); const v2u ow = *(const v2u*)(OP + (size_t)m * 1024 + idx);
            const f32x4 op = {bf_lo(ow.x), bf_hi(ow.x), bf_lo(ow.y), bf_hi(ow.y)};
            f32x4 hc;
#pragma unroll
            for (int e = 0; e < 4; ++e) hc[e] = ht[e] / (1.f + __expf(-op[e]));
            const float mu = wave_sum((hc.x + hc.y) + (hc.z + hc.w), lane) * (1.f / 256.f);
            hc = hc - mu;
            const float var = wave_sum((hc.x * hc.x + hc.y * hc.y) + (hc.z * hc.z + hc.w * hc.w), lane) * (1.f / 256.f);
            const float rstd = 1.f / sqrtf(var + LN_EPS);
            const f32x4 ng = *(const f32x4*)(norm_g + idx);
            const f32x4 o = hc * rstd * ng;
            v2u w; w.x = pk2(o.x, o.y); w.y = pk2(o.z, o.w);
            *(v2u*)(HN + (size_t)m * 1024 + idx) = w; }
    }
}
__global__ void __launch_bounds__(512, 2) fwd_megakernel(Args a) {
    extern __shared__ __attribute__((aligned(16))) unsigned char lds_raw[];
    cg::grid_group grid = cg::this_grid();
    LAS unsigned char* lds = (LAS unsigned char*)lds_raw;
    const int G = gridDim.x, bx = blockIdx.x, NGW = G * 8, NT = G * 512;
#define LAUNDER_TID() int tid = threadIdx.x; asm volatile("" : "+v"(tid)); const int lane = tid & 63, wave = __builtin_amdgcn_readfirstlane(tid >> 6), gw = bx * 8 + wave, gt = bx * 512 + tid; (void)lane; (void)gw; (void)gt;
    unsigned char* ws = a.ws;
    bf16* XB = (bf16*)(ws + WS_XB); float* Y = (float*)(ws + WS_Y); bf16* HB = (bf16*)(ws + WS_HB); unsigned char* mx = ws + WS_MX;
    float* X = a.out;

    { LAUNDER_TID(); p0_prologue(a, lds, gw, NGW, wave, lane); }
    grid.sync();

#pragma unroll 1
    for (int st = 0; st < 12; ++st) {
        LAUNDER_TID();
        const int layer = st / 3, sub = st - layer * 3;
        const float* Xin = (st == 0) ? a.x : X;
        const bf16* Aop; const bf16* Bt; int K; float cmul;
        if (sub != 1) {
            const int fi = layer * 2 + (sub == 2 ? 1 : 0);
            { pg8::Gemm g{XB, (const bf16*)(ws + WS_WGU + fi * SZ_WGU), M, 2 * FF, D}; pg8::StaticOrder S; S.init(M, 2 * FF, G, bx);
              pg8::EpiSwiglu E{HB, FF};
              pg8::gemm_phase<pg8::EpiSwiglu, pg8::StaticOrder, true, true>(lds, g, S, E); }
            grid.sync();
            Aop = HB; Bt = (const bf16*)(ws + WS_WD + fi * SZ_WD); K = FF; cmul = 0.5f;
        } else {
            const int kind = layer % 3, j = layer / 3;
            if (kind == 0) {
                bf16* QK = (bf16*)(mx + MX_QK); bf16* VT = (bf16*)(mx + MX_VT); bf16* O = (bf16*)(mx + MX_O); float* KMEAN = (float*)(mx + MX_KMEAN); unsigned* KN = (unsigned*)(mx + MX_KN);
                const bf16* Win = (const bf16*)(ws + WS_AIN + j * SZ_AIN);
                { pg8::Gemm g{XB, Win, M, 2048, D}; pg8::StaticOrder S; S.init(M, 2048, G, bx); pg8::EpiBf16 E{QK, 2048};
                  pg8::gemm_phase<pg8::EpiBf16, pg8::StaticOrder, true, true>(lds, g, S, E); }
                { pg8::Gemm g{Win + (size_t)2048 * 1024, XB, 1024, M, D}; pg8::StaticOrder S; S.init(1024, M, G, bx); pg8::EpiBf16 E{VT, M};
                  pg8::gemm_phase<pg8::EpiBf16, pg8::StaticOrder, true, true>(lds, g, S, E); }
                grid.sync();
                kmean_phase(QK, KMEAN, KN, lds, tid, G);
                grid.sync();
                attn_mfma_phase(QK, VT, KMEAN, KN, a.rel_bias, O, lds, tid, G);
                grid.sync();
                Aop = O; Bt = (const bf16*)(ws + WS_AOUT + j * SZ_SQ); K = D; cmul = 1.0f;
            } else if (kind == 1) {
                bf16* U = (bf16*)(mx + MX_U); bf16* P = (bf16*)(mx + MX_P);
                { pg8::Gemm g{XB, (const bf16*)(ws + WS_BIN), M, D, D}; pg8::StaticOrder S; S.init(M, D, G, bx); pg8::EpiBf16 E{U, D};
                  pg8::gemm_phase<pg8::EpiBf16, pg8::StaticOrder, true, true>(lds, g, S, E); }
                grid.sync();
                pool_phase(U, P, gt, NT);
                grid.sync();
                Aop = P; Bt = (const bf16*)(ws + WS_BCOMB); K = D; cmul = 1.0f;
            } else {
                bf16* QKP = (bf16*)(mx + MX_QKP); bf16* KVT = (bf16*)(mx + MX_KVT); bf16* OP = (bf16*)(mx + MX_OP); bf16* QC = (bf16*)(mx + MX_QC); bf16* KC = (bf16*)(mx + MX_KC); bf16* KT = (bf16*)(mx + MX_KT);
                float* HT = (float*)(ws + WS_HB); float* GATES = (float*)(mx + MX_GATES); bf16* HN = (bf16*)(mx + MX_HN2);
                const bf16* Wc = (const bf16*)(ws + WS_CIN);
                { pg8::Gemm g{XB, Wc, M, 2048, D}; pg8::StaticOrder S; S.init(M, 2048, G, bx); pg8::EpiBf16 E{QKP, 2048};
                  pg8::gemm_phase<pg8::EpiBf16, pg8::StaticOrder, true, true>(lds, g, S, E); }
                { pg8::Gemm g{Wc + (size_t)1024 * 1024, XB, 2048, M, D}; pg8::StaticOrder S; S.init(2048, M, G, bx); pg8::EpiBf16 E{KVT, M};
                  pg8::gemm_phase<pg8::EpiBf16, pg8::StaticOrder, true, true>(lds, g, S, E); }
                { pg8::Gemm g{XB, Wc + (size_t)3072 * 1024, M, D, D}; pg8::StaticOrder S; S.init(M, D, G, bx); pg8::EpiBf16 E{OP, D};
                  pg8::gemm_phase<pg8::EpiBf16, pg8::StaticOrder, true, true>(lds, g, S, E); }
                gates_phase(Xin, a.c_w_in, a.c_b_gates, GATES, gw, NGW, lane);
                grid.sync();
                conv2_phase(QKP, KVT, a.c_conv_w, QC, KC, KT, gt, NT);
                grid.sync();
                mlstm_mfma_phase(QC, KC, KT, KVT, GATES, HT, lds, tid, G);
                grid.sync();
                headnorm2_phase(HT, OP, a.c_norm_g, HN, gw, NGW, lane);
                grid.sync();
                Aop = HN; Bt = (const bf16*)(ws + WS_COUT); K = D; cmul = 1.0f;
            }
        }
        { pg8::Gemm g{Aop, Bt, M, D, K}; pg8::StaticOrder S; S.init(M, D, G, bx); pg8::EpiPreLN E{Xin, Y, ALPHA, cmul};
          pg8::gemm_phase<pg8::EpiPreLN, pg8::StaticOrder, true, true>(lds, g, S, E); }
        grid.sync();
        ln_phase(Y, a.ln_g + (size_t)st * D, a.ln_b + (size_t)st * D, X, XB, gw, NGW, lane);
        grid.sync();
    }
}

extern "C" void kernel_launch(void* const* d_in, const int* in_sizes, int n_in, void* d_out, int out_size, void* d_ws, size_t ws_size, hipStream_t stream) {
    static int grid = 0;
    if (grid == 0) {
        if (n_in != 17 || out_size != M * D || ws_size < WS_END) { fprintf(stderr, "kernel_launch: unexpected shapes (n_in %d out %d ws %zu need %zu)\n", n_in, out_size, ws_size, (size_t)WS_END); grid = -1; return; }
        int dev = 0, cus = 0, per_cu = 0;
        (void)hipGetDevice(&dev); (void)hipDeviceGetAttribute(&cus, hipDeviceAttributeMultiprocessorCount, dev);
        if (hipFuncSetAttribute((const void*)fwd_megakernel, hipFuncAttributeMaxDynamicSharedMemorySize, LDS_BYTES) != hipSuccess) { fprintf(stderr, "kernel_launch: hipFuncSetAttribute failed\n"); grid = -1; return; }
        if (hipOccupancyMaxActiveBlocksPerMultiprocessor(&per_cu, (const void*)fwd_megakernel, 512, LDS_BYTES) != hipSuccess || per_cu < 1) { fprintf(stderr, "kernel_launch: occupancy query gives %d\n", per_cu); per_cu = 1; }
        (void)hipGetLastError();
        grid = cus * 1;
    }
    if (grid < 0) return;
    Args a{};
    a.x = (const float*)d_in[0]; a.rel_bias = (const float*)d_in[1]; a.ln_g = (const float*)d_in[2]; a.ln_b = (const float*)d_in[3];
    a.ffn_w_gu = (const float*)d_in[4]; a.ffn_w_down = (const float*)d_in[5]; a.a_w_in = (const float*)d_in[6]; a.a_w_out = (const float*)d_in[7];
    a.b_w_in = (const float*)d_in[8]; a.b_w_group = (const float*)d_in[9]; a.b_scale = (const float*)d_in[10]; a.b_w_out = (const float*)d_in[11];
    a.c_w_in = (const float*)d_in[12]; a.c_b_gates = (const float*)d_in[13]; a.c_conv_w = (const float*)d_in[14]; a.c_norm_g = (const float*)d_in[15]; a.c_w_out = (const float*)d_in[16];
    a.out = (float*)d_out; a.ws = (unsigned char*)d_ws;
    void* args[] = {&a};
    hipError_t e = hipLaunchCooperativeKernel((const void*)fwd_megakernel, dim3(grid), dim3(512), args, LDS_BYTES, stream);
    if (e != hipSuccess) fprintf(stderr, "kernel_launch: cooperative launch failed: %s (grid %d)\n", hipGetErrorString(e), grid);
}
```
